# Optimizing an MI355X kernel written in HIP

```python
import math
import jax
import jax.numpy as jnp
from jax import lax
import numpy as np

D_MODEL = 1024
BATCH = 32
SEQ = 256
DEPTH = 4
DEC_BATCH = 2
DEC_SEQ = 4096
PAST_LEN = 256

GRID_W = 64
EPS = 1e-6
MIX_WIDTH = D_MODEL
POOL_WIDTH = D_MODEL // 4
POOL_GROUPS = 4
POOL_GROUP_DIM = POOL_WIDTH // POOL_GROUPS
POOL_WINDOWS = (2, 4, 8, 16)
GLA_HEADS = 4
GLA_DV = 64
GLA_DK = 32
GLA_WIDTH = GLA_HEADS * GLA_DV
GLA_GATE_RANK = 16
GLA_GATE_TAU = 16.0
GLA_CHUNK = 64
ATTN_HEADS = 8
ATTN_KV_HEADS = 2
ATTN_GROUP = ATTN_HEADS // ATTN_KV_HEADS
HEAD_DIM = 64
ATTN_WIDTH = ATTN_HEADS * HEAD_DIM
WINDOW = 128
ATTN_BLOCK = 128
ROPE_THETA = 10000.0
NEG_INF = -1e30
PEER_HEADS = 8
PEER_N_KEYS = 128
PEER_N_EXPERTS = PEER_N_KEYS * PEER_N_KEYS
PEER_QUERY_DIM = 128
PEER_TOPK = 16
PEER_TOKEN_BLOCK = 128
IN_SIZES = (POOL_WIDTH, GLA_HEADS * GLA_DK, GLA_HEADS * GLA_DK, GLA_WIDTH, GLA_WIDTH, GLA_GATE_RANK, GLA_GATE_RANK, ATTN_HEADS * HEAD_DIM, ATTN_KV_HEADS * HEAD_DIM, ATTN_KV_HEADS * HEAD_DIM)
IN_WIDTH = 1824

kernel_name = 'hybrid_pool_gla_swa_peer_dit_step'


def _rmsnorm(x, g):
    xf = x.astype(jnp.float32)
    y = xf * lax.rsqrt(jnp.mean(xf * xf, axis=-1, keepdims=True) + EPS)
    return (y * g.astype(jnp.float32)).astype(x.dtype)


def _split_proj(p):
    cuts = np.cumsum(IN_SIZES)[:-1].tolist()
    return jnp.split(p, cuts, axis=-1)


def _pool_mix(x, w, scale):
    B, T, _ = x.shape
    xg = x.reshape(B, T, POOL_GROUPS, POOL_GROUP_DIM)
    cs = jnp.concatenate([jnp.zeros((B, 1, POOL_GROUPS, POOL_GROUP_DIM), jnp.float32),
                          jnp.cumsum(xg.astype(jnp.float32), axis=1)], axis=1)
    t = jnp.arange(T)
    diffs = []
    for g, win in enumerate(POOL_WINDOWS):
        left = win // 2
        right = win - 1 - left
        lo = jnp.maximum(t - left, 0)
        hi = jnp.minimum(t + right + 1, T)
        csg = cs[:, :, g]
        mean = (csg[:, hi] - csg[:, lo]) / (hi - lo).astype(jnp.float32)[None, :, None]
        diffs.append(mean.astype(x.dtype) - xg[:, :, g])
    d = jnp.stack(diffs, axis=2)
    y = jnp.einsum('btgc,gcd->btgd', d, w)
    return y.reshape(B, T, POOL_WIDTH) * scale


def _gla_log_decay(z, w2, b2):
    B, T, _ = z.shape
    logit = (z @ w2 + b2).astype(jnp.float32)
    return (jax.nn.log_sigmoid(logit) / GLA_GATE_TAU).reshape(B, T, GLA_HEADS, GLA_DK)


def _gla_scan(q, k, v, log_a, s0):
    B, T, H, dk = q.shape
    dv = v.shape[-1]
    C = GLA_CHUNK
    nc = T // C

    def chunks(a):
        return a.astype(jnp.float32).reshape(B, nc, C, H, a.shape[-1]).transpose(1, 0, 3, 2, 4)

    qc, kc, vc, ac = chunks(q), chunks(k), chunks(v), chunks(log_a)
    causal = jnp.tril(jnp.ones((C, C), dtype=bool))[:, :, None]

    def step(S, inp):
        qb, kb, vb, ab = inp
        b = jnp.cumsum(ab, axis=2)
        inter = jnp.einsum('bhtd,bhde->bhte', qb * jnp.exp(b), S)
        diff = b[:, :, :, None, :] - b[:, :, None, :, :]
        decay = jnp.where(causal, jnp.exp(jnp.where(causal, diff, 0.0)), 0.0)
        scores = jnp.einsum('bhtd,bhsd,bhtsd->bhts', qb, kb, decay)
        intra = jnp.einsum('bhts,bhse->bhte', scores, vb)
        b_last = b[:, :, -1:, :]
        S_new = jnp.exp(b_last[:, :, 0, :])[..., None] * S + jnp.einsum('bhsd,bhse->bhde', kb * jnp.exp(b_last - b), vb)
        return S_new, inter + intra

    S, o = lax.scan(step, s0.astype(jnp.float32), (qc, kc, vc, ac))
    o = o.transpose(1, 0, 3, 2, 4).reshape(B, T, H, dv)
    return o.astype(v.dtype), S.astype(s0.dtype)


def _gla_bidir(q, k, v, la_f, la_b, s0_f, s0_b):
    o_f, s_f = _gla_scan(q, k, v, la_f, s0_f)
    rev = lambda a: jnp.flip(a, axis=1)
    o_b, s_b = _gla_scan(rev(q), rev(k), rev(v), rev(la_b), s0_b)
    return o_f + rev(o_b), s_f, s_b


def _gla_output(o, g, norm_g):
    B, T, H, dv = o.shape
    of = o.astype(jnp.float32)
    of = of * lax.rsqrt(jnp.mean(of * of, axis=-1, keepdims=True) + EPS)
    of = of * norm_g.reshape(H, dv).astype(jnp.float32)
    return of.reshape(B, T, H * dv).astype(o.dtype) * jax.nn.silu(g)


def _axial_rope(x, pos_row, pos_col):
    half = HEAD_DIM // 2
    nf = half // 2
    freqs = ROPE_THETA ** (-jnp.arange(nf, dtype=jnp.float32) / nf)

    def rot(xa, pos):
        ang = pos.astype(jnp.float32)[:, None] * freqs[None, :]
        cos = jnp.cos(ang)[None, :, None, :]
        sin = jnp.sin(ang)[None, :, None, :]
        x1, x2 = xa[..., :nf], xa[..., nf:]
        return jnp.concatenate([x1 * cos - x2 * sin, x1 * sin + x2 * cos], axis=-1)

    xf = x.astype(jnp.float32)
    return jnp.concatenate([rot(xf[..., :half], pos_row), rot(xf[..., half:], pos_col)], axis=-1).astype(x.dtype)


def _context_attention(q, k, v, sink):
    B, T, _, _ = q.shape
    nqb = T // ATTN_BLOCK
    scale = HEAD_DIM ** -0.5
    qb = q.reshape(B, nqb, ATTN_BLOCK, ATTN_KV_HEADS, ATTN_GROUP, HEAD_DIM).transpose(1, 0, 2, 3, 4, 5)
    sink_b = sink.reshape(ATTN_KV_HEADS, ATTN_GROUP).astype(jnp.float32)

    def one(qblk):
        s = jnp.einsum('bqgrd,bkgd->bgrqk', qblk, k).astype(jnp.float32) * scale
        sk = jnp.broadcast_to(sink_b[None, :, :, None, None], s.shape[:-1] + (1,))
        p = jax.nn.softmax(jnp.concatenate([s, sk], axis=-1), axis=-1)[..., :-1]
        return jnp.einsum('bgrqk,bkgd->bqgrd', p.astype(v.dtype), v)

    o = lax.map(one, qb)
    return o.transpose(1, 0, 2, 3, 4, 5).reshape(B, T, ATTN_WIDTH)


def _latent_attention(q, k, v, ck, cv, sink):
    B, T, _, _ = q.shape
    nb = T // ATTN_BLOCK
    scale = HEAD_DIM ** -0.5
    qb = q.reshape(B, nb, ATTN_BLOCK, ATTN_KV_HEADS, ATTN_GROUP, HEAD_DIM)
    pad = jnp.zeros((B, ATTN_BLOCK, ATTN_KV_HEADS, HEAD_DIM), k.dtype)

    def band(a):
        ap = jnp.concatenate([pad, a, pad], axis=1).reshape(B, nb + 2, ATTN_BLOCK, ATTN_KV_HEADS, HEAD_DIM)
        return jnp.concatenate([ap[:, :-2], ap[:, 1:-1], ap[:, 2:]], axis=2)

    kw, vw = band(k), band(v)
    blk = jnp.arange(nb)
    qpos = blk[:, None] * ATTN_BLOCK + jnp.arange(ATTN_BLOCK)[None, :]
    kpos = (blk[:, None] - 1) * ATTN_BLOCK + jnp.arange(3 * ATTN_BLOCK)[None, :]
    mask = ((jnp.abs(qpos[:, :, None] - kpos[:, None, :]) <= WINDOW)
            & (kpos >= 0)[:, None, :] & (kpos < T)[:, None, :])
    s_loc = jnp.einsum('bnqgrd,bnkgd->bngrqk', qb, kw).astype(jnp.float32) * scale
    s_loc = jnp.where(mask[None, :, None, None], s_loc, NEG_INF)
    s_ctx = jnp.einsum('bnqgrd,bkgd->bngrqk', qb, ck).astype(jnp.float32) * scale
    s_sink = jnp.broadcast_to(sink.reshape(ATTN_KV_HEADS, ATTN_GROUP).astype(jnp.float32)[None, None, :, :, None, None],
                              s_loc.shape[:-1] + (1,))
    p = jax.nn.softmax(jnp.concatenate([s_loc, s_ctx, s_sink], axis=-1), axis=-1)
    L = 3 * ATTN_BLOCK
    Lc = ck.shape[1]
    out = (jnp.einsum('bngrqk,bnkgd->bnqgrd', p[..., :L].astype(v.dtype), vw)
           + jnp.einsum('bngrqk,bkgd->bnqgrd', p[..., L:L + Lc].astype(v.dtype), cv))
    return out.reshape(B, T, ATTN_WIDTH)


def _peer(h, wq, subkeys, u, v):
    B, T, D = h.shape
    n = B * T
    hf = h.reshape(n, D)
    q = (hf @ wq).reshape(n, PEER_HEADS, 2, PEER_QUERY_DIM // 2)
    s = jnp.einsum('nhpd,hpkd->nhpk', q, subkeys).astype(jnp.float32)
    sv, si = lax.top_k(s, PEER_TOPK)
    cand = (sv[:, :, 0, :, None] + sv[:, :, 1, None, :]).reshape(n, PEER_HEADS, PEER_TOPK * PEER_TOPK)
    cand_idx = (si[:, :, 0, :, None] * PEER_N_KEYS + si[:, :, 1, None, :]).reshape(n, PEER_HEADS, PEER_TOPK * PEER_TOPK)
    top_v, top_pos = lax.top_k(cand, PEER_TOPK)
    experts = jnp.take_along_axis(cand_idx, top_pos, axis=-1)
    gates = jax.nn.softmax(top_v, axis=-1).astype(h.dtype)
    nblk = n // PEER_TOKEN_BLOCK
    xs = (hf.reshape(nblk, PEER_TOKEN_BLOCK, D),
          experts.reshape(nblk, PEER_TOKEN_BLOCK, PEER_HEADS * PEER_TOPK),
          gates.reshape(nblk, PEER_TOKEN_BLOCK, PEER_HEADS * PEER_TOPK))

    def blk_fn(args):
        xb, eb, gb = args
        act = jax.nn.gelu(jnp.einsum('td,tkd->tk', xb, u[eb]), approximate=False)
        return jnp.einsum('tk,tkd->td', gb * act, v[eb])

    y = lax.map(blk_fn, xs)
    return y.reshape(B, T, D)


def _trunk_layer(x, cvec, lp, ctx, pos):
    (w_ada, b_ada, n1, n2, w_in, pool_w, pool_scale, gla_w_f, gla_b_f, gla_w_b, gla_b_b,
     gla_norm, sink, w_out, peer_wq, peer_subkeys, peer_u, peer_v) = lp
    B, T, _ = x.shape
    sh1, sc1, gt1, sh2, sc2, gt2 = jnp.split(jax.nn.silu(cvec) @ w_ada + b_ada, 6, axis=-1)
    h = _rmsnorm(x, n1) * (1 + sc1) + sh1
    p_pool, gq, gk, gv, gg, gz_f, gz_b, aq, ak, av = _split_proj(h @ w_in)
    y_pool = _pool_mix(p_pool, pool_w, pool_scale)
    gq = gq.reshape(B, T, GLA_HEADS, GLA_DK) * GLA_DK ** -0.5
    gk = gk.reshape(B, T, GLA_HEADS, GLA_DK)
    gv = gv.reshape(B, T, GLA_HEADS, GLA_DV)
    la_f = _gla_log_decay(gz_f, gla_w_f, gla_b_f)
    la_b = _gla_log_decay(gz_b, gla_w_b, gla_b_b)
    aq = aq.reshape(B, T, ATTN_HEADS, HEAD_DIM)
    ak = ak.reshape(B, T, ATTN_KV_HEADS, HEAD_DIM)
    av = av.reshape(B, T, ATTN_KV_HEADS, HEAD_DIM)
    if ctx is None:
        s0 = jnp.zeros((B, GLA_HEADS, GLA_DK, GLA_DV), x.dtype)
        o, s_f, s_b = _gla_bidir(gq, gk, gv, la_f, la_b, s0, s0)
        y_attn = _context_attention(aq, ak, av, sink)
    else:
        ck, cv, s0_f, s0_b = ctx
        o, s_f, s_b = _gla_bidir(gq, gk, gv, la_f, la_b, s0_f, s0_b)
        pos_row, pos_col = pos
        aq = _axial_rope(aq, pos_row, pos_col)
        ak = _axial_rope(ak, pos_row, pos_col)
        y_attn = _latent_attention(aq, ak, av, ck, cv, sink)
    y_gla = _gla_output(o, gg, gla_norm)
    mix = jnp.concatenate([y_pool, y_gla, y_attn], axis=-1)
    x = x + gt1 * (mix @ w_out)
    h2 = _rmsnorm(x, n2) * (1 + sc2) + sh2
    x = x + gt2 * _peer(h2, peer_wq, peer_subkeys, peer_u, peer_v)
    return x, ak, av, s_f, s_b


def setup_inputs(seed: int = 0) -> dict:
    key = jax.random.key(seed)
    ks = jax.random.split(key, 27)
    D = D_MODEL

    def nrm(k, shape, s):
        return s * jax.random.normal(k, shape, jnp.float32)

    return {
        'x_prompt': nrm(ks[0], (BATCH, SEQ, D), 1.0),
        'x_sample': nrm(ks[1], (DEC_BATCH, DEC_SEQ, D), 1.0),
        'cache_k': nrm(ks[2], (DEC_BATCH, DEPTH, PAST_LEN, ATTN_KV_HEADS, HEAD_DIM), 1.0),
        'cache_v': nrm(ks[3], (DEC_BATCH, DEPTH, PAST_LEN, ATTN_KV_HEADS, HEAD_DIM), 1.0),
        'state_fwd': nrm(ks[4], (DEC_BATCH, DEPTH, GLA_HEADS, GLA_DK, GLA_DV), 0.5),
        'state_bwd': nrm(ks[5], (DEC_BATCH, DEPTH, GLA_HEADS, GLA_DK, GLA_DV), 0.5),
        'c': nrm(ks[6], (DEC_BATCH, D), 1.0),
        'c_ctx': nrm(ks[7], (D,), 1.0),
        'w_ada': nrm(ks[8], (DEPTH, D, 6 * D), 0.5 * D ** -0.5),
        'b_ada': nrm(ks[9], (DEPTH, 6 * D), 0.01),
        'norm1_g': 1.0 + nrm(ks[10], (DEPTH, D), 0.02),
        'norm2_g': 1.0 + nrm(ks[11], (DEPTH, D), 0.02),
        'w_in': nrm(ks[12], (DEPTH, D, IN_WIDTH), D ** -0.5),
        'pool_w': nrm(ks[13], (DEPTH, POOL_GROUPS, POOL_GROUP_DIM, POOL_GROUP_DIM), POOL_GROUP_DIM ** -0.5),
        'pool_scale': 1.0 + nrm(ks[14], (DEPTH, POOL_WIDTH), 0.1),
        'gla_gate_w_f': nrm(ks[15], (DEPTH, GLA_GATE_RANK, GLA_HEADS * GLA_DK), GLA_GATE_RANK ** -0.5),
        'gla_gate_b_f': nrm(ks[16], (DEPTH, GLA_HEADS * GLA_DK), 0.01),
        'gla_gate_w_b': nrm(ks[17], (DEPTH, GLA_GATE_RANK, GLA_HEADS * GLA_DK), GLA_GATE_RANK ** -0.5),
        'gla_gate_b_b': nrm(ks[18], (DEPTH, GLA_HEADS * GLA_DK), 0.01),
        'gla_norm_g': 1.0 + nrm(ks[19], (DEPTH, GLA_WIDTH), 0.02),
        'attn_sink': nrm(ks[20], (DEPTH, ATTN_HEADS), 0.5),
        'w_out': nrm(ks[21], (DEPTH, MIX_WIDTH, D), MIX_WIDTH ** -0.5),
        'peer_wq': nrm(ks[22], (DEPTH, D, PEER_HEADS * PEER_QUERY_DIM), D ** -0.5),
        'peer_subkeys': nrm(ks[23], (DEPTH, PEER_HEADS, 2, PEER_N_KEYS, PEER_QUERY_DIM // 2), (PEER_QUERY_DIM // 2) ** -0.5),
        'peer_u': nrm(ks[24], (DEPTH, PEER_N_EXPERTS, D), D ** -0.5),
        'peer_v': nrm(ks[25], (DEPTH, PEER_N_EXPERTS, D), D ** -0.5),
        'final_norm_g': 1.0 + nrm(ks[26], (D,), 0.02),
    }


def reference(x_prompt, x_sample, cache_k, cache_v, state_fwd, state_bwd, c, c_ctx,
              w_ada, b_ada, norm1_g, norm2_g, w_in, pool_w, pool_scale,
              gla_gate_w_f, gla_gate_b_f, gla_gate_w_b, gla_gate_b_b, gla_norm_g,
              attn_sink, w_out, peer_wq, peer_subkeys, peer_u, peer_v, final_norm_g):
    layer_params = (w_ada, b_ada, norm1_g, norm2_g, w_in, pool_w, pool_scale,
                    gla_gate_w_f, gla_gate_b_f, gla_gate_w_b, gla_gate_b_b, gla_norm_g,
                    attn_sink, w_out, peer_wq, peer_subkeys, peer_u, peer_v)
    xc = x_prompt
    c_ctx_b = c_ctx[None, None, :]
    ks_l, vs_l, sf_l, sb_l = [], [], [], []
    for l in range(DEPTH):
        lp = tuple(p[l] for p in layer_params)
        xc, k_l, v_l, s_f, s_b = _trunk_layer(xc, c_ctx_b, lp, None, None)
        ks_l.append(k_l)
        vs_l.append(v_l)
        sf_l.append(s_f)
        sb_l.append(s_b)
    y_prompt = _rmsnorm(xc, final_norm_g)
    new_cache_k = jnp.stack(ks_l, axis=1)
    new_cache_v = jnp.stack(vs_l, axis=1)
    new_state_fwd = jnp.stack(sf_l, axis=1)
    new_state_bwd = jnp.stack(sb_l, axis=1)
    n_lat = x_sample.shape[1]
    rows = n_lat // GRID_W
    pos = (jnp.repeat(jnp.arange(rows), GRID_W), jnp.tile(jnp.arange(GRID_W), rows))
    xs = x_sample
    c_b = c[:, None, :]
    for l in range(DEPTH):
        lp = tuple(p[l] for p in layer_params)
        ctx = (cache_k[:, l], cache_v[:, l], state_fwd[:, l], state_bwd[:, l])
        xs, _, _, _, _ = _trunk_layer(xs, c_b, lp, ctx, pos)
    y_sample = _rmsnorm(xs, final_norm_g)
    return (y_prompt, y_sample, new_cache_k, new_cache_v, new_state_fwd, new_state_bwd)
```

```cpp
#include <hip/hip_runtime.h>
#include <cstdio>
#include <cstdint>

#define LAS __attribute__((address_space(3)))
#define RLX_AGENT __ATOMIC_RELAXED, __HIP_MEMORY_SCOPE_AGENT

constexpr int D = 1024, NTOK = 16384, NCTX = 8192, NLAYER = 4;
constexpr int INW = 1824;
constexpr int C_POOL = 0, C_GQ = 256, C_GK = 384, C_GV = 512, C_GG = 768, C_ZF = 1024, C_ZB = 1040, C_AQ = 1056, C_AK = 1568, C_AV = 1696;
constexpr int NT = 512, NWAVES = 8;
constexpr int LDS_BYTES = 147456;
constexpr float EPS = 1e-6f;

constexpr size_t MiB = 1u << 20;
constexpr size_t WS_CTL = 0, CTL_ZERO_BYTES = 1 * MiB;
constexpr size_t WS_MOD = 1 * MiB;
constexpr size_t WS_X = 64 * MiB;
constexpr size_t WS_H = 128 * MiB;
constexpr size_t WS_P = 192 * MiB;
constexpr size_t WS_MIX = 320 * MiB;
constexpr size_t WS_OF = 384 * MiB;
constexpr size_t WS_OB = 400 * MiB;
constexpr size_t WS_ALF = 416 * MiB;
constexpr size_t WS_ALB = 424 * MiB;
constexpr size_t WS_KR = 432 * MiB;
constexpr size_t WS_Q = 448 * MiB;
constexpr size_t WS_TOPK = 512 * MiB;
constexpr size_t WS_EXP = 528 * MiB;
constexpr size_t WS_GATE = 536 * MiB;
constexpr size_t WS_END = 544 * MiB;
constexpr int CW_BAR = 4096;

#define XB_TMO      128
#define XB_XCNT(j)  (256  + 64 * (j))
#define XB_XSUB(j)  (1280 + 64 * (j))
#define XB_XGEN(j)  (2304 + 64 * (j))
#define XB_TOP      3328
#define XB_TOPGEN   3392
#define XCD_BAR_WORDS 3456
#define XB_SPIN_CAP (1u << 23)

__device__ __forceinline__ unsigned xb_ld(unsigned* p)              { return __hip_atomic_load(p, __ATOMIC_RELAXED, __HIP_MEMORY_SCOPE_AGENT); }
__device__ __forceinline__ unsigned xb_add(unsigned* p, unsigned v) { return __hip_atomic_fetch_add(p, v, __ATOMIC_RELAXED, __HIP_MEMORY_SCOPE_AGENT); }
__device__ __forceinline__ unsigned xb_xcc_id() { return (unsigned)__builtin_amdgcn_s_getreg((3 << 11) | 20) & 0xFu; }
#define XB_SPIN(cond, bar) do { unsigned _sp = 0; while (cond) { __builtin_amdgcn_s_sleep(1); \
    if ((++_sp & 255u) == 0u) { if (xb_ld(&(bar)[XB_TMO])) break; if (_sp > XB_SPIN_CAP) { atomicAdd(&(bar)[XB_TMO], 1u); break; } } } } while (0)

struct XcdBarrier { unsigned* bar; unsigned x; volatile LAS unsigned* st; };

__device__ __forceinline__ XcdBarrier xcd_barrier_post(unsigned* bar, volatile LAS unsigned* st) {
    XcdBarrier b; b.bar = bar; b.x = xb_xcc_id(); b.st = st;
    if (threadIdx.x == 0) (void)xb_add(&bar[XB_XCNT(b.x)], 1u);
    return b;
}
__device__ __forceinline__ void xcd_barrier_complete(unsigned* bar, unsigned x, unsigned& nloc, unsigned& nx) {
    const unsigned G = gridDim.x * gridDim.y * gridDim.z;
    unsigned sum, cnt, mine, sp = 0u;
    for (;;) {
        sum = 0u; cnt = 0u; mine = 0u;
#pragma unroll
        for (unsigned j = 0; j < 16; ++j) { const unsigned c = xb_ld(&bar[XB_XCNT(j)]); sum += c; cnt += (c > 0u) ? 1u : 0u; mine = (j == x) ? c : mine; }
        if (sum == G) break;
        __builtin_amdgcn_s_sleep(1);
        if ((++sp & 255u) == 0u) { if (xb_ld(&bar[XB_TMO])) break; if (sp > XB_SPIN_CAP) { atomicAdd(&bar[XB_TMO], 1u); break; } }
    }
    nloc = mine > 0u ? mine : 1u; nx = cnt > 0u ? cnt : 1u;
}
__device__ __forceinline__ void xcd_barrier(const XcdBarrier& b) {
    asm volatile("s_waitcnt vmcnt(0)" ::: "memory");
    __syncthreads();
    if (threadIdx.x == 0) {
        unsigned* bar = b.bar;
        __builtin_amdgcn_s_waitcnt(0);
        unsigned nloc = b.st[0], nx = b.st[1];
        if (nloc == 0u) { xcd_barrier_complete(bar, b.x, nloc, nx); b.st[0] = nloc; b.st[1] = nx; }
        const unsigned old = xb_add(&bar[XB_XSUB(b.x)], 1u);
        const unsigned gen = old / nloc;
        if (old + 1u == (gen + 1u) * nloc) {
            __builtin_amdgcn_fence(__ATOMIC_RELEASE, "agent");
            asm volatile("s_waitcnt vmcnt(0)" ::: "memory");
            const unsigned og = xb_add(&bar[XB_TOP], 1u);
            const unsigned tg = og / nx;
            if (og + 1u == (tg + 1u) * nx) xb_add(&bar[XB_TOPGEN], 1u);
            else XB_SPIN(xb_ld(&bar[XB_TOPGEN]) == tg, bar);
            __builtin_amdgcn_fence(__ATOMIC_ACQUIRE, "agent");
            xb_add(&bar[XB_XGEN(b.x)], 1u);
            asm volatile("s_waitcnt vmcnt(0)" ::: "memory");
        } else {
            XB_SPIN(xb_ld(&bar[XB_XGEN(b.x)]) == gen, bar);
            __builtin_amdgcn_fence(__ATOMIC_ACQUIRE, "agent");
            asm volatile("s_waitcnt vmcnt(0)" ::: "memory");
        }
    }
    __syncthreads();
}

typedef float f32x4 __attribute__((ext_vector_type(4)));
__device__ __forceinline__ float wave_sum(float v) {
#pragma unroll
    for (int o = 1; o < 64; o <<= 1) v += __shfl_xor(v, o);
    return v;
}
__device__ __forceinline__ int lv(int v) { asm volatile("" : "+v"(v)); return v; }
__device__ __forceinline__ int ls(int v) { asm volatile("" : "+s"(v)); return v; }
#define TID lv((int)threadIdx.x)
#define BID ls((int)blockIdx.x)
#define GDIM ls((int)gridDim.x)
__device__ __forceinline__ int grp_of(int t) { return t < NCTX ? 0 : 1 + ((t - NCTX) >> 12); }
__device__ __forceinline__ float siluf(float x) { return x / (1.f + expf(-x)); }
__device__ __forceinline__ float log_sigmoidf(float x) { return fminf(x, 0.f) - log1pf(expf(-fabsf(x))); }

struct Args { const float* in[27]; float* out; unsigned char* ws; };
enum { I_XP = 0, I_XS, I_CK, I_CV, I_SF, I_SB, I_C, I_CCTX, I_WADA, I_BADA, I_N1, I_N2, I_WIN, I_POOLW, I_POOLS, I_GWF, I_GBF, I_GWB, I_GBB, I_GNORM, I_SINK, I_WOUT, I_WQ, I_SUBK, I_PU, I_PV, I_FNORM };
constexpr size_t OUT_YP = 0, OUT_YS = 8388608, OUT_CK = 16777216, OUT_CV = 20971520, OUT_SF = 25165824, OUT_SB = 26214400;

__device__ __forceinline__ void phase_prologue(const Args& a, float* lds) {
    const int tid = TID, bid = BID, gdim = GDIM;
    float* MOD = (float*)(a.ws + WS_MOD);
    for (int it = bid; it < NLAYER * 96; it += gdim) {
        const int l = it / 96, cb = it % 96;
        float* sl = lds;
        for (int i = tid; i < 3 * D; i += NT) { const int g = i >> 10, k = i & 1023; const float c = (g == 0) ? a.in[I_CCTX][k] : a.in[I_C][(g - 1) * D + k]; sl[i] = siluf(c); }
        __syncthreads();
        const int cl = tid & 63, ks = tid >> 6;
        float a0 = 0.f, a1 = 0.f, a2 = 0.f;
        const float* w = a.in[I_WADA] + ((size_t)l * D + ks * 128) * 6144 + cb * 64 + cl;
        for (int k = 0; k < 128; ++k) { const float wv = w[(size_t)k * 6144]; const int kk = ks * 128 + k; a0 += sl[kk] * wv; a1 += sl[D + kk] * wv; a2 += sl[2 * D + kk] * wv; }
        float* red = sl + 3 * D;
        red[(ks * 3 + 0) * 64 + cl] = a0; red[(ks * 3 + 1) * 64 + cl] = a1; red[(ks * 3 + 2) * 64 + cl] = a2;
        __syncthreads();
        if (tid < 192) { const int g = tid >> 6, c = tid & 63; float s = a.in[I_BADA][l * 6144 + cb * 64 + c];
            for (int q = 0; q < 8; ++q) s += red[(q * 3 + g) * 64 + c];
            MOD[(size_t)(l * 3 + g) * 6144 + cb * 64 + c] = s; }
        __syncthreads();
    }
    f32x4* X4 = (f32x4*)(a.ws + WS_X);
    const f32x4* xp = (const f32x4*)a.in[I_XP]; const f32x4* xs = (const f32x4*)a.in[I_XS];
    const int n4 = NCTX * D / 4;
    for (int i = bid * NT + tid; i < 2 * n4; i += gdim * NT) X4[i] = i < n4 ? xp[i] : xs[i - n4];
}

__device__ __forceinline__ void phase_norm(const float* X, const float* gain, const float* modl, int sh_off, int sc_off, float* H) {
    const int tid = TID, bid = BID, gdim = GDIM, lane = tid & 63, gw = bid * NWAVES + (tid >> 6), ngw = gdim * NWAVES;
    for (int t = gw; t < NTOK; t += ngw) {
        const f32x4* xr = (const f32x4*)(X + (size_t)t * D) + lane;
        f32x4 v[4]; float ss = 0.f;
#pragma unroll
        for (int j = 0; j < 4; ++j) { v[j] = xr[64 * j]; ss += v[j].x * v[j].x + v[j].y * v[j].y + v[j].z * v[j].z + v[j].w * v[j].w; }
        ss = wave_sum(ss);
        const float r = 1.0f / sqrtf(ss * (1.f / D) + EPS);
        const float* m = modl + grp_of(t) * 6144;
        f32x4* hr = (f32x4*)(H + (size_t)t * D) + lane;
#pragma unroll
        for (int j = 0; j < 4; ++j) { const int col = 4 * (lane + 64 * j);
            const f32x4 g = *(const f32x4*)(gain + col), sc = *(const f32x4*)(m + sc_off + col), sh = *(const f32x4*)(m + sh_off + col);
            hr[64 * j] = v[j] * r * g * (sc + 1.0f) + sh; }
    }
}

template <class Epi>
__device__ __forceinline__ void gemm_f32(const float* A, const float* B, int M, int N, int K, float* lds, const Epi& epi) {
    const int tid = TID, bid = BID, gdim = GDIM, tx = tid & 31, ty = tid >> 5;
    float* As = lds; float* Bs = lds + 16 * 132;
    const int ntm = M / 128, ntn = (N + 127) / 128;
    for (int tile = bid; tile < ntm * ntn; tile += gdim) {
        const int tm = tile / ntn, tn = tile % ntn;
        float acc[8][4];
#pragma unroll
        for (int i = 0; i < 8; ++i)
#pragma unroll
            for (int j = 0; j < 4; ++j) acc[i][j] = 0.f;
        const float* ap = A + (size_t)(tm * 128 + (tid >> 2)) * K + 4 * (tid & 3);
        const int bn = tn * 128 + 4 * (tid & 31);
        const float* bp = B + (size_t)(tid >> 5) * N + bn;
        for (int k0 = 0; k0 < K; k0 += 16) {
            const f32x4 av = *(const f32x4*)(ap + k0);
            const f32x4 bv = bn < N ? *(const f32x4*)(bp + (size_t)k0 * N) : (f32x4){0.f, 0.f, 0.f, 0.f};
            __syncthreads();
            As[(4 * (tid & 3) + 0) * 132 + (tid >> 2)] = av.x; As[(4 * (tid & 3) + 1) * 132 + (tid >> 2)] = av.y;
            As[(4 * (tid & 3) + 2) * 132 + (tid >> 2)] = av.z; As[(4 * (tid & 3) + 3) * 132 + (tid >> 2)] = av.w;
            *(f32x4*)&Bs[(tid >> 5) * 132 + 4 * (tid & 31)] = bv;
            __syncthreads();
#pragma unroll
            for (int kk = 0; kk < 16; ++kk) {
                const f32x4 a0 = *(const f32x4*)&As[kk * 132 + ty * 8], a1 = *(const f32x4*)&As[kk * 132 + ty * 8 + 4], b = *(const f32x4*)&Bs[kk * 132 + tx * 4];
                const float aa[8] = {a0.x, a0.y, a0.z, a0.w, a1.x, a1.y, a1.z, a1.w}; const float bb[4] = {b.x, b.y, b.z, b.w};
#pragma unroll
                for (int i = 0; i < 8; ++i)
#pragma unroll
                    for (int j = 0; j < 4; ++j) acc[i][j] += aa[i] * bb[j];
            }
        }
#pragma unroll
        for (int i = 0; i < 8; ++i)
#pragma unroll
            for (int j = 0; j < 4; ++j) { const int row = tm * 128 + ty * 8 + i, col = tn * 128 + tx * 4 + j; if (col < N) epi(row, col, acc[i][j]); }
        __syncthreads();
    }
}

struct EpiInProj { float* P; float* out; int l;
    __device__ __forceinline__ void operator()(int row, int col, float v) const {
        P[(size_t)row * INW + col] = v;
        if (row < NCTX && col >= C_AK) { const int b = row >> 8, tt = row & 255, c = col - C_AK;
            const size_t base = ((size_t)(b * NLAYER + l) * 256 + tt) * 128;
            if (c < 128) out[OUT_CK + base + c] = v; else out[OUT_CV + base + c - 128] = v; }
    } };
struct EpiResid { float* X; const float* modl; int gate_off;
    __device__ __forceinline__ void operator()(int row, int col, float v) const {
        const float g = modl[grp_of(row) * 6144 + gate_off + col]; X[(size_t)row * D + col] += g * v; } };
struct EpiStore { float* Q;
    __device__ __forceinline__ void operator()(int row, int col, float v) const { Q[(size_t)row * D + col] = v; } };

__device__ __forceinline__ void phase_mixprep(const Args& a, int l, float* lds) {
    const int tid = TID, bid = BID, gdim = GDIM;
    const float* P = (const float*)(a.ws + WS_P); float* MIX = (float*)(a.ws + WS_MIX);
    for (int t = bid; t < NTOK; t += gdim) {
        int s0, T; if (t < NCTX) { s0 = t & ~255; T = 256; } else { s0 = NCTX + ((t - NCTX) & ~4095); T = 4096; }
        const int tt = t - s0;
        float* df = lds;
        if (tid < 256) { const int g = tid >> 6, win = 2 << g, left = win / 2, right = win - 1 - left;
            const int lo = max(tt - left, 0), hi = min(tt + right + 1, T);
            float s = 0.f; for (int u = lo; u < hi; ++u) s += P[(size_t)(s0 + u) * INW + tid];
            df[tid] = s / (float)(hi - lo) - P[(size_t)t * INW + tid]; }
        __syncthreads();
        if (tid < 256) { const int g = tid >> 6, d = tid & 63; const float* w = a.in[I_POOLW] + (size_t)((l * 4 + g) * 64) * 64 + d;
            float s = 0.f; for (int c = 0; c < 64; ++c) s += df[g * 64 + c] * w[c * 64];
            MIX[(size_t)t * D + tid] = s * a.in[I_POOLS][l * 256 + tid]; }
        __syncthreads();
    }
    float* ALF = (float*)(a.ws + WS_ALF); float* ALB = (float*)(a.ws + WS_ALB);
    for (int i = bid * NT + tid; i < NTOK * 256; i += gdim * NT) {
        const int t = i >> 8, j = i & 127, dir = (i >> 7) & 1;
        const float* z = P + (size_t)t * INW + (dir ? C_ZB : C_ZF);
        const float* w = a.in[dir ? I_GWB : I_GWF] + (size_t)l * 16 * 128 + j;
        float s = a.in[dir ? I_GBB : I_GBF][l * 128 + j];
#pragma unroll
        for (int r = 0; r < 16; ++r) s += z[r] * w[r * 128];
        (dir ? ALB : ALF)[(size_t)t * 128 + j] = expf(log_sigmoidf(s) * (1.f / 16.f));
    }
    float* KR = (float*)(a.ws + WS_KR);
    for (int i = bid * NT + tid; i < NCTX * 128; i += gdim * NT) {
        const int tl = i >> 7, c = i & 127, d = c & 63, half = d >> 5, second = (d >> 4) & 1, fi = d & 15;
        const int pos = half ? (tl & 63) : ((tl & 4095) >> 6);
        const float ang = (float)pos * powf(10000.f, -(float)fi / 16.f);
        float sn, cs; sincosf(ang, &sn, &cs);
        const float* kp = P + (size_t)(NCTX + tl) * INW + C_AK + (c & 64) + half * 32;
        const float x1 = kp[fi], x2 = kp[16 + fi];
        KR[i] = second ? (x1 * sn + x2 * cs) : (x1 * cs - x2 * sn);
    }
}

__device__ __forceinline__ void phase_gla_scan(const Args& a, int l) {
    const int tid = TID, bid = BID, gdim = GDIM, lane = tid & 63, gw = bid * NWAVES + (tid >> 6), ngw = gdim * NWAVES;
    const float* P = (const float*)(a.ws + WS_P);
    for (int item = gw; item < 34 * 8; item += ngw) {
        int seq, h, dir;
        if (item < 16) { seq = 32 + (item >> 3); h = (item >> 1) & 3; dir = item & 1; }
        else { const int r = item - 16; seq = r >> 3; h = (r >> 1) & 3; dir = r & 1; }
        const int s0 = seq < 32 ? seq * 256 : NCTX + (seq - 32) * 4096, T = seq < 32 ? 256 : 4096;
        float S[32];
        if (seq < 32) {
#pragma unroll
            for (int k = 0; k < 32; ++k) S[k] = 0.f;
        } else {
            const float* st = a.in[dir ? I_SB : I_SF] + (size_t)(((seq - 32) * NLAYER + l) * 4 + h) * 2048;
#pragma unroll
            for (int k = 0; k < 32; ++k) S[k] = st[k * 64 + lane];
        }
        const float* AL = (const float*)(a.ws + (dir ? WS_ALB : WS_ALF)); float* O = (float*)(a.ws + (dir ? WS_OB : WS_OF));
        for (int step = 0; step < T; ++step) {
            const int t = s0 + (dir ? T - 1 - step : step);
            const float* pr = P + (size_t)t * INW; const float* al = AL + (size_t)t * 128 + h * 32;
            const float v = pr[C_GV + h * 64 + lane];
            float o = 0.f;
#pragma unroll
            for (int k = 0; k < 32; ++k) { S[k] = al[k] * S[k] + pr[C_GK + h * 32 + k] * v; o += pr[C_GQ + h * 32 + k] * S[k]; }
            O[(size_t)t * 256 + h * 64 + lane] = o * 0.17677669529663687f;
        }
        if (seq < 32) { float* dst = a.out + (dir ? OUT_SB : OUT_SF) + (size_t)((seq * NLAYER + l) * 4 + h) * 2048;
#pragma unroll
            for (int k = 0; k < 32; ++k) dst[k * 64 + lane] = S[k]; }
    }
}

__device__ __forceinline__ void phase_attn(const Args& a, int l) {
    const float* P = (const float*)(a.ws + WS_P); const float* KR = (const float*)(a.ws + WS_KR); float* MIX = (float*)(a.ws + WS_MIX);
    const int tid = TID, bid = BID, gdim = GDIM;
    for (int idx = bid * NT + tid; idx < NTOK * 8 * 4; idx += gdim * NT) {
        const int j = idx & 3, r = idx >> 2, hq = r >> 14, t = r & 16383, kv = hq >> 2, dof = 16 * j;
        float q[16], acc[16];
        { const float* qp = P + (size_t)t * INW + C_AQ + hq * 64 + dof;
#pragma unroll
          for (int d = 0; d < 16; ++d) { q[d] = qp[d]; acc[d] = 0.f; } }
        if (t >= NCTX) { const int tl = (t - NCTX) & 4095; const int pos = (j >> 1) ? (tl & 63) : (tl >> 6);
#pragma unroll
            for (int fi = 0; fi < 16; ++fi) { float sn, cs; sincosf((float)pos * powf(10000.f, -(float)fi / 16.f), &sn, &cs);
                const float mine = q[fi], other = __shfl_xor(mine, 1);
                q[fi] = (j & 1) ? (other * sn + mine * cs) : (mine * cs - other * sn); } }
#pragma unroll
        for (int d = 0; d < 16; ++d) q[d] *= 0.125f;
        float m = a.in[I_SINK][l * 8 + hq], lsum = 1.f;
        auto key = [&](const float* kp, const float* vp) {
            float s = 0.f;
#pragma unroll
            for (int d = 0; d < 16; d += 4) { const f32x4 kk = *(const f32x4*)(kp + dof + d); s += q[d] * kk.x + q[d + 1] * kk.y + q[d + 2] * kk.z + q[d + 3] * kk.w; }
            s += __shfl_xor(s, 1); s += __shfl_xor(s, 2);
            if (s > m) { const float sc = expf(m - s); lsum *= sc;
#pragma unroll
                for (int d = 0; d < 16; ++d) acc[d] *= sc;
                m = s; }
            const float p = expf(s - m); lsum += p;
#pragma unroll
            for (int d = 0; d < 16; d += 4) { const f32x4 vv = *(const f32x4*)(vp + dof + d); acc[d] += p * vv.x; acc[d + 1] += p * vv.y; acc[d + 2] += p * vv.z; acc[d + 3] += p * vv.w; }
        };
        if (t < NCTX) { const int s0 = t & ~255;
            for (int s = s0; s < s0 + 256; ++s) key(P + (size_t)s * INW + C_AK + kv * 64, P + (size_t)s * INW + C_AV + kv * 64);
        } else { const int b = (t - NCTX) >> 12, tl = (t - NCTX) & 4095, s0 = NCTX + b * 4096;
            const int lo = max(tl - 128, 0), hi = min(tl + 128, 4095);
            for (int s = lo; s <= hi; ++s) key(KR + (size_t)(b * 4096 + s) * 128 + kv * 64, P + (size_t)(s0 + s) * INW + C_AV + kv * 64);
            const float* ck = a.in[I_CK] + (size_t)(b * NLAYER + l) * 256 * 128 + kv * 64; const float* cv = a.in[I_CV] + (size_t)(b * NLAYER + l) * 256 * 128 + kv * 64;
            for (int s = 0; s < 256; ++s) key(ck + s * 128, cv + s * 128);
        }
        const float inv = 1.f / lsum; float* op = MIX + (size_t)t * D + 512 + hq * 64 + dof;
#pragma unroll
        for (int d = 0; d < 16; d += 4) *(f32x4*)(op + d) = (f32x4){acc[d] * inv, acc[d + 1] * inv, acc[d + 2] * inv, acc[d + 3] * inv};
    }
}

__device__ __forceinline__ void phase_gla_out(const Args& a, int l) {
    const int tid = TID, bid = BID, gdim = GDIM, lane = tid & 63, gw = bid * NWAVES + (tid >> 6), ngw = gdim * NWAVES;
    const float* P = (const float*)(a.ws + WS_P); const float* OF = (const float*)(a.ws + WS_OF); const float* OB = (const float*)(a.ws + WS_OB); float* MIX = (float*)(a.ws + WS_MIX);
    for (int it = gw; it < NTOK * 4; it += ngw) {
        const int t = it >> 2, h = it & 3;
        const float o = OF[(size_t)t * 256 + h * 64 + lane] + OB[(size_t)t * 256 + h * 64 + lane];
        const float ms = wave_sum(o * o) * (1.f / 64.f);
        const float g = P[(size_t)t * INW + C_GG + h * 64 + lane];
        MIX[(size_t)t * D + 256 + h * 64 + lane] = o * (1.0f / sqrtf(ms + EPS)) * a.in[I_GNORM][l * 256 + h * 64 + lane] * siluf(g);
    }
}

__device__ __forceinline__ void phase_topk1(const Args& a, int l) {
    const float* Q = (const float*)(a.ws + WS_Q); float* TOPK = (float*)(a.ws + WS_TOPK);
    const int tid = TID, bid = BID, gdim = GDIM;
    for (int idx = bid * NT + tid; idx < NTOK * 16; idx += gdim * NT) {
        const int hp = idx >> 14, t = idx & 16383;
        float q[64];
        { const float* qp = Q + (size_t)t * D + hp * 64;
#pragma unroll
          for (int d = 0; d < 64; ++d) q[d] = qp[d]; }
        float top[16];
#pragma unroll
        for (int i = 0; i < 16; ++i) top[i] = -3.0e38f;
        const float* sk = a.in[I_SUBK] + (size_t)(l * 16 + hp) * 128 * 64;
        for (int k = 0; k < 128; ++k) {
            float s = 0.f;
#pragma unroll
            for (int d = 0; d < 64; ++d) s += q[d] * sk[k * 64 + d];
            float x = __uint_as_float((__float_as_uint(s) & ~127u) | (unsigned)k);
#pragma unroll
            for (int i = 0; i < 16; ++i) { const float hi = fmaxf(top[i], x); x = fminf(top[i], x); top[i] = hi; }
        }
        float* o = TOPK + ((size_t)t * 16 + hp) * 16;
#pragma unroll
        for (int i = 0; i < 16; i += 4) *(f32x4*)(o + i) = (f32x4){top[i], top[i + 1], top[i + 2], top[i + 3]};
    }
}
__device__ __forceinline__ void phase_topk2(const Args& a) {
    const float* TOPK = (const float*)(a.ws + WS_TOPK); int* EXP = (int*)(a.ws + WS_EXP); float* GATE = (float*)(a.ws + WS_GATE);
    const int tid = TID, bid = BID, gdim = GDIM;
    for (int idx = bid * NT + tid; idx < NTOK * 8; idx += gdim * NT) {
        const int t = idx >> 3, h = idx & 7;
        const float* pa = TOPK + ((size_t)t * 16 + 2 * h) * 16; const float* pb = pa + 16;
        float va[16], vb[16];
#pragma unroll
        for (int i = 0; i < 16; ++i) { va[i] = __uint_as_float(__float_as_uint(pa[i]) & ~127u); vb[i] = __uint_as_float(__float_as_uint(pb[i]) & ~127u); }
        float top[16];
#pragma unroll
        for (int i = 0; i < 16; ++i) top[i] = -3.0e38f;
#pragma unroll
        for (int i = 0; i < 16; ++i)
#pragma unroll
            for (int j = 0; j < 16 / (i + 1); ++j) {
                float x = __uint_as_float((__float_as_uint(va[i] + vb[j]) & ~255u) | (unsigned)(i * 16 + j));
#pragma unroll
                for (int k = 0; k < 16; ++k) { const float hi = fmaxf(top[k], x); x = fminf(top[k], x); top[k] = hi; }
            }
        float e[16], sum = 0.f; const float m = __uint_as_float(__float_as_uint(top[0]) & ~255u);
#pragma unroll
        for (int k = 0; k < 16; ++k) { e[k] = expf(__uint_as_float(__float_as_uint(top[k]) & ~255u) - m); sum += e[k]; }
        const float inv = 1.f / sum;
#pragma unroll
        for (int k = 0; k < 16; ++k) { const unsigned pos = __float_as_uint(top[k]) & 255u;
            const unsigned ei = __float_as_uint(pa[pos >> 4]) & 127u, ej = __float_as_uint(pb[pos & 15u]) & 127u;
            EXP[(size_t)t * 128 + h * 16 + k] = (int)(ei * 128u + ej); GATE[(size_t)t * 128 + h * 16 + k] = e[k] * inv; }
    }
}
__device__ __forceinline__ void phase_peer(const Args& a, int l) {
    const int tid = TID, bid = BID, gdim = GDIM, lane = tid & 63, gw = bid * NWAVES + (tid >> 6), ngw = gdim * NWAVES;
    const float* H = (const float*)(a.ws + WS_H); float* X = (float*)(a.ws + WS_X);
    const int* EXP = (const int*)(a.ws + WS_EXP); const float* GATE = (const float*)(a.ws + WS_GATE);
    const float* MOD = (const float*)(a.ws + WS_MOD) + (size_t)l * 3 * 6144;
    for (int t = gw; t < NTOK; t += ngw) {
        const f32x4* hr = (const f32x4*)(H + (size_t)t * D) + lane;
        f32x4 hv[4], y[4];
#pragma unroll
        for (int j = 0; j < 4; ++j) { hv[j] = hr[64 * j]; y[j] = (f32x4){0.f, 0.f, 0.f, 0.f}; }
        for (int k = 0; k < 128; ++k) {
            const int e = EXP[(size_t)t * 128 + k]; const float g = GATE[(size_t)t * 128 + k];
            const f32x4* ur = (const f32x4*)(a.in[I_PU] + ((size_t)l * 16384 + e) * D) + lane;
            const f32x4* vr = (const f32x4*)(a.in[I_PV] + ((size_t)l * 16384 + e) * D) + lane;
            float d = 0.f;
#pragma unroll
            for (int j = 0; j < 4; ++j) { const f32x4 u = ur[64 * j]; d += u.x * hv[j].x + u.y * hv[j].y + u.z * hv[j].z + u.w * hv[j].w; }
            d = wave_sum(d);
            const float c = g * 0.5f * d * (1.f + erff(d * 0.70710678118654752f));
#pragma unroll
            for (int j = 0; j < 4; ++j) y[j] += vr[64 * j] * c;
        }
        const float* gt = MOD + grp_of(t) * 6144 + 5 * D;
        f32x4* xr = (f32x4*)(X + (size_t)t * D) + lane;
#pragma unroll
        for (int j = 0; j < 4; ++j) { const f32x4 g4 = *(const f32x4*)(gt + 4 * (lane + 64 * j)); xr[64 * j] = xr[64 * j] + g4 * y[j]; }
    }
}
__device__ __forceinline__ void phase_final(const Args& a) {
    const int tid = TID, bid = BID, gdim = GDIM, lane = tid & 63, gw = bid * NWAVES + (tid >> 6), ngw = gdim * NWAVES;
    const float* X = (const float*)(a.ws + WS_X);
    for (int t = gw; t < NTOK; t += ngw) {
        const f32x4* xr = (const f32x4*)(X + (size_t)t * D) + lane;
        f32x4 v[4]; float ss = 0.f;
#pragma unroll
        for (int j = 0; j < 4; ++j) { v[j] = xr[64 * j]; ss += v[j].x * v[j].x + v[j].y * v[j].y + v[j].z * v[j].z + v[j].w * v[j].w; }
        ss = wave_sum(ss);
        const float r = 1.0f / sqrtf(ss * (1.f / D) + EPS);
        f32x4* o = (f32x4*)(a.out + (size_t)t * D) + lane;
#pragma unroll
        for (int j = 0; j < 4; ++j) o[64 * j] = v[j] * r * *(const f32x4*)(a.in[I_FNORM] + 4 * (lane + 64 * j));
    }
}

__global__ void __launch_bounds__(NT, 2) mega_fwd(Args a) {
    extern __shared__ __attribute__((aligned(16))) unsigned char lds[];
    float* ldsf = (float*)lds;
    volatile LAS unsigned* MISC = (volatile LAS unsigned*)((LAS unsigned char*)lds + 131072 + 320);
    if (threadIdx.x < 32) MISC[threadIdx.x] = 0u;
    __syncthreads();
    XcdBarrier bar = xcd_barrier_post((unsigned*)(a.ws + WS_CTL) + CW_BAR, MISC + 8);
#define GRID_BAR() xcd_barrier(bar)
    float* X = (float*)(a.ws + WS_X); float* H = (float*)(a.ws + WS_H); float* P = (float*)(a.ws + WS_P); float* MIX = (float*)(a.ws + WS_MIX); float* Q = (float*)(a.ws + WS_Q);
    phase_prologue(a, ldsf);
    GRID_BAR();
    for (int l = 0; l < NLAYER; ++l) {
        const float* MODL = (const float*)(a.ws + WS_MOD) + (size_t)l * 3 * 6144;
        phase_norm(X, a.in[I_N1] + l * D, MODL, 0, D, H);
        GRID_BAR();
        gemm_f32(H, a.in[I_WIN] + (size_t)l * D * INW, NTOK, INW, D, ldsf, EpiInProj{P, a.out, l});
        GRID_BAR();
        phase_mixprep(a, l, ldsf);
        GRID_BAR();
        phase_gla_scan(a, l);
        phase_attn(a, l);
        GRID_BAR();
        phase_gla_out(a, l);
        GRID_BAR();
        gemm_f32(MIX, a.in[I_WOUT] + (size_t)l * D * D, NTOK, D, D, ldsf, EpiResid{X, MODL, 2 * D});
        GRID_BAR();
        phase_norm(X, a.in[I_N2] + l * D, MODL, 3 * D, 4 * D, H);
        GRID_BAR();
        gemm_f32(H, a.in[I_WQ] + (size_t)l * D * D, NTOK, D, D, ldsf, EpiStore{Q});
        GRID_BAR();
        phase_topk1(a, l);
        GRID_BAR();
        phase_topk2(a);
        GRID_BAR();
        phase_peer(a, l);
        GRID_BAR();
    }
    phase_final(a);
}

extern "C" void kernel_launch(void* const* d_in, const int* in_sizes, int n_in, void* d_out, int out_size, void* d_ws, size_t ws_size, hipStream_t stream) {
    static int grid = 0;
    if (grid == 0) {
        if (n_in != 27 || ws_size < WS_END) { fprintf(stderr, "kernel_launch: unexpected n_in %d / ws %zu\n", n_in, ws_size); grid = -1; return; }
        int dev = 0, cus = 0;
        if (hipGetDevice(&dev) != hipSuccess || hipDeviceGetAttribute(&cus, hipDeviceAttributeMultiprocessorCount, dev) != hipSuccess) { grid = -1; return; }
        if (hipFuncSetAttribute((const void*)mega_fwd, hipFuncAttributeMaxDynamicSharedMemorySize, LDS_BYTES) != hipSuccess) { fprintf(stderr, "kernel_launch: hipFuncSetAttribute failed\n"); grid = -1; return; }
        int per_cu = 0;
        if (hipOccupancyMaxActiveBlocksPerMultiprocessor(&per_cu, (const void*)mega_fwd, NT, LDS_BYTES) != hipSuccess || per_cu < 1) fprintf(stderr, "kernel_launch: occupancy query says %d\n", per_cu);
        (void)hipGetLastError();
        grid = cus;
    }
    if (grid < 0) return;
    if (hipMemsetAsync((char*)d_ws + WS_CTL, 0, CTL_ZERO_BYTES, stream) != hipSuccess) return;
    Args a{};
    for (int i = 0; i < 27; ++i) a.in[i] = (const float*)d_in[i];
    a.out = (float*)d_out; a.ws = (unsigned char*)d_ws;
    hipLaunchKernelGGL(mega_fwd, dim3(grid), dim3(NT), LDS_BYTES, stream, a);
}
```

```cpp
#include <hip/hip_runtime.h>
#include <cstdio>
#include <cstdint>

#define LAS __attribute__((address_space(3)))
#define RLX_AGENT __ATOMIC_RELAXED, __HIP_MEMORY_SCOPE_AGENT

constexpr int D = 1024, NTOK = 16384, NCTX = 8192, NLAYER = 4;
constexpr int INW = 1824;
constexpr int C_POOL = 0, C_GQ = 256, C_GK = 384, C_GV = 512, C_GG = 768, C_ZF = 1024, C_ZB = 1040, C_AQ = 1056, C_AK = 1568, C_AV = 1696;
constexpr int NT = 512, NWAVES = 8;
constexpr int LDS_BYTES = 147456;
constexpr float EPS = 1e-6f;

constexpr size_t MiB = 1u << 20;
constexpr size_t WS_CTL = 0, CTL_ZERO_BYTES = 1 * MiB;
constexpr size_t WS_MOD = 1 * MiB;
constexpr size_t WS_WIN_T = 2 * MiB;
constexpr size_t WS_WOUT_T = 18 * MiB;
constexpr size_t WS_WQ_T = 26 * MiB;
constexpr size_t WS_X = 64 * MiB;
constexpr size_t WS_H = 128 * MiB;
constexpr size_t WS_P = 192 * MiB;
constexpr size_t WS_MIX = 320 * MiB;
constexpr size_t WS_DS = 384 * MiB;
constexpr size_t WS_SST = 400 * MiB;
constexpr size_t WS_DEC = 416 * MiB;
constexpr size_t WS_Q = 448 * MiB;
constexpr size_t WS_EXP = 528 * MiB;
constexpr size_t WS_GATE = 536 * MiB;
constexpr size_t WS_U8 = 544 * MiB;
constexpr size_t WS_V8 = 608 * MiB;
constexpr size_t WS_SUV = 672 * MiB;
constexpr size_t WS_ROPE = 673 * MiB;
constexpr size_t WS_SKB = 674 * MiB;
constexpr size_t WS_END = 676 * MiB;
constexpr int CW_BAR = 4096;

#define XB_TMO      128
#define XB_XCNT(j)  (256  + 64 * (j))
#define XB_XSUB(j)  (1280 + 64 * (j))
#define XB_XGEN(j)  (2304 + 64 * (j))
#define XB_TOP      3328
#define XB_TOPGEN   3392
#define XCD_BAR_WORDS 3456
#define XB_SPIN_CAP (1u << 23)

__device__ __forceinline__ unsigned xb_ld(unsigned* p)              { return __hip_atomic_load(p, __ATOMIC_RELAXED, __HIP_MEMORY_SCOPE_AGENT); }
__device__ __forceinline__ unsigned xb_add(unsigned* p, unsigned v) { return __hip_atomic_fetch_add(p, v, __ATOMIC_RELAXED, __HIP_MEMORY_SCOPE_AGENT); }
__device__ __forceinline__ unsigned xb_xcc_id() { return (unsigned)__builtin_amdgcn_s_getreg((3 << 11) | 20) & 0xFu; }
#define XB_SPIN(cond, bar) do { unsigned _sp = 0; while (cond) { __builtin_amdgcn_s_sleep(1); \
    if ((++_sp & 255u) == 0u) { if (xb_ld(&(bar)[XB_TMO])) break; if (_sp > XB_SPIN_CAP) { atomicAdd(&(bar)[XB_TMO], 1u); break; } } } } while (0)

struct XcdBarrier { unsigned* bar; unsigned x; volatile LAS unsigned* st; };

__device__ __forceinline__ XcdBarrier xcd_barrier_post(unsigned* bar, volatile LAS unsigned* st) {
    XcdBarrier b; b.bar = bar; b.x = xb_xcc_id(); b.st = st;
    if (threadIdx.x == 0) (void)xb_add(&bar[XB_XCNT(b.x)], 1u);
    return b;
}
__device__ __forceinline__ void xcd_barrier_complete(unsigned* bar, unsigned x, unsigned& nloc, unsigned& nx) {
    const unsigned G = gridDim.x * gridDim.y * gridDim.z;
    unsigned sum, cnt, mine, sp = 0u;
    for (;;) {
        sum = 0u; cnt = 0u; mine = 0u;
#pragma unroll
        for (unsigned j = 0; j < 16; ++j) { const unsigned c = xb_ld(&bar[XB_XCNT(j)]); sum += c; cnt += (c > 0u) ? 1u : 0u; mine = (j == x) ? c : mine; }
        if (sum == G) break;
        __builtin_amdgcn_s_sleep(1);
        if ((++sp & 255u) == 0u) { if (xb_ld(&bar[XB_TMO])) break; if (sp > XB_SPIN_CAP) { atomicAdd(&bar[XB_TMO], 1u); break; } }
    }
    nloc = mine > 0u ? mine : 1u; nx = cnt > 0u ? cnt : 1u;
}
__device__ __forceinline__ void xcd_barrier(const XcdBarrier& b) {
    asm volatile("s_waitcnt vmcnt(0)" ::: "memory");
    __syncthreads();
    if (threadIdx.x == 0) {
        unsigned* bar = b.bar; asm volatile("" : "+s"(bar));
        __builtin_amdgcn_s_waitcnt(0);
        unsigned nloc = b.st[0], nx = b.st[1]; unsigned bx = b.x; asm volatile("" : "+s"(bx));
        if (nloc == 0u) { xcd_barrier_complete(bar, bx, nloc, nx); b.st[0] = nloc; b.st[1] = nx; }
        const unsigned old = xb_add(&bar[XB_XSUB(bx)], 1u);
        const unsigned gen = old / nloc;
        if (old + 1u == (gen + 1u) * nloc) {
            __builtin_amdgcn_fence(__ATOMIC_RELEASE, "agent");
            asm volatile("s_waitcnt vmcnt(0)" ::: "memory");
            const unsigned og = xb_add(&bar[XB_TOP], 1u);
            const unsigned tg = og / nx;
            if (og + 1u == (tg + 1u) * nx) xb_add(&bar[XB_TOPGEN], 1u);
            else XB_SPIN(xb_ld(&bar[XB_TOPGEN]) == tg, bar);
            __builtin_amdgcn_fence(__ATOMIC_ACQUIRE, "agent");
            xb_add(&bar[XB_XGEN(bx)], 1u);
            asm volatile("s_waitcnt vmcnt(0)" ::: "memory");
        } else {
            XB_SPIN(xb_ld(&bar[XB_XGEN(bx)]) == gen, bar);
            __builtin_amdgcn_fence(__ATOMIC_ACQUIRE, "agent");
            asm volatile("s_waitcnt vmcnt(0)" ::: "memory");
        }
    }
    __syncthreads();
}

typedef float f32x4 __attribute__((ext_vector_type(4)));
__device__ __forceinline__ float wave_sum(float v) {
#pragma unroll
    for (int o = 1; o < 64; o <<= 1) v += __shfl_xor(v, o);
    return v;
}
template <int CTRL> __device__ __forceinline__ float dpp_mov(float x) { return __builtin_bit_cast(float, __builtin_amdgcn_update_dpp(0, __builtin_bit_cast(int, x), CTRL, 0xf, 0xf, true)); }
__device__ __forceinline__ float wave_sum_u(float x) {
    x += dpp_mov<0xB1>(x);
    x += dpp_mov<0x4E>(x);
    x += dpp_mov<0x141>(x);
    x += dpp_mov<0x140>(x);
    const int xi = __builtin_bit_cast(int, x);
    const float s0 = __builtin_bit_cast(float, __builtin_amdgcn_readlane(xi, 0)), s1 = __builtin_bit_cast(float, __builtin_amdgcn_readlane(xi, 16));
    const float s2 = __builtin_bit_cast(float, __builtin_amdgcn_readlane(xi, 32)), s3 = __builtin_bit_cast(float, __builtin_amdgcn_readlane(xi, 48));
    return (s0 + s1) + (s2 + s3);
}
__device__ __forceinline__ float wave_max_u(float x) {
    x = fmaxf(x, dpp_mov<0xB1>(x)); x = fmaxf(x, dpp_mov<0x4E>(x)); x = fmaxf(x, dpp_mov<0x141>(x)); x = fmaxf(x, dpp_mov<0x140>(x));
    const int xi = __builtin_bit_cast(int, x);
    const float s0 = __builtin_bit_cast(float, __builtin_amdgcn_readlane(xi, 0)), s1 = __builtin_bit_cast(float, __builtin_amdgcn_readlane(xi, 16));
    const float s2 = __builtin_bit_cast(float, __builtin_amdgcn_readlane(xi, 32)), s3 = __builtin_bit_cast(float, __builtin_amdgcn_readlane(xi, 48));
    return fmaxf(fmaxf(s0, s1), fmaxf(s2, s3));
}
__device__ __forceinline__ float wave_prefix_incl(float x, int lane) {
    x += dpp_mov<0x111>(x); x += dpp_mov<0x112>(x); x += dpp_mov<0x114>(x); x += dpp_mov<0x118>(x);
    const int xi = __builtin_bit_cast(int, x);
    const float t0 = __builtin_bit_cast(float, __builtin_amdgcn_readlane(xi, 15)), t1 = __builtin_bit_cast(float, __builtin_amdgcn_readlane(xi, 31)), t2 = __builtin_bit_cast(float, __builtin_amdgcn_readlane(xi, 47));
    return x + (lane >= 48 ? (t0 + t1) + t2 : lane >= 32 ? t0 + t1 : lane >= 16 ? t0 : 0.f);
}
__device__ __forceinline__ float wave_suffix_incl(float x, int lane) {
    x += dpp_mov<0x101>(x); x += dpp_mov<0x102>(x); x += dpp_mov<0x104>(x); x += dpp_mov<0x108>(x);
    const int xi = __builtin_bit_cast(int, x);
    const float r1 = __builtin_bit_cast(float, __builtin_amdgcn_readlane(xi, 16)), r2 = __builtin_bit_cast(float, __builtin_amdgcn_readlane(xi, 32)), r3 = __builtin_bit_cast(float, __builtin_amdgcn_readlane(xi, 48));
    return x + (lane < 16 ? (r1 + r2) + r3 : lane < 32 ? r2 + r3 : lane < 48 ? r3 : 0.f);
}
__device__ __forceinline__ float log_sigmoid_fast(float x) { return fminf(x, 0.f) - __logf(1.f + __expf(-fabsf(x))); }
__device__ __forceinline__ int lv(int v) { asm volatile("" : "+v"(v)); return v; }
__device__ __forceinline__ int ls(int v) { asm volatile("" : "+s"(v)); return v; }
#define TID lv((int)threadIdx.x)
#define BID ls((int)blockIdx.x)
#define GDIM ls((int)gridDim.x)
__device__ __forceinline__ int grp_of(int t) { return t < NCTX ? 0 : 1 + ((t - NCTX) >> 12); }
__device__ __forceinline__ float siluf(float x) { return x * __builtin_amdgcn_rcpf(1.f + __expf(-x)); }

struct KArgs { const float* in[27]; float* out; unsigned char* ws; };
struct InTab { volatile LAS unsigned* t; unsigned char* ws;
    __device__ __forceinline__ const float* operator[](int i) const {
        unsigned off = 8u * (unsigned)i; asm volatile("" : "+v"(off));
        volatile LAS unsigned* e = (volatile LAS unsigned*)((LAS unsigned char*)t + off);
        const unsigned lo = __builtin_amdgcn_readfirstlane(e[0]), hi = __builtin_amdgcn_readfirstlane(e[1]);
        return (const float*)(ws + (long long)(((unsigned long long)hi << 32) | lo)); } };
struct Args { InTab in; float* out; unsigned char* ws; };
#define GAS __attribute__((address_space(1)))
__device__ __forceinline__ Args fresh(const Args& a) {
    GAS float* o = (GAS float*)a.out; GAS unsigned char* w = (GAS unsigned char*)a.ws;
    asm volatile("" : "+s"(o)); asm volatile("" : "+s"(w));
    Args b = a; b.out = (float*)o; b.ws = (unsigned char*)w; b.in.ws = b.ws; return b; }
__device__ __forceinline__ unsigned char* fresh_lds(unsigned char* p) { LAS unsigned char* q = (LAS unsigned char*)p; asm volatile("" : "+s"(q)); return (unsigned char*)q; }
enum { I_XP = 0, I_XS, I_CK, I_CV, I_SF, I_SB, I_C, I_CCTX, I_WADA, I_BADA, I_N1, I_N2, I_WIN, I_POOLW, I_POOLS, I_GWF, I_GBF, I_GWB, I_GBB, I_GNORM, I_SINK, I_WOUT, I_WQ, I_SUBK, I_PU, I_PV, I_FNORM };
constexpr size_t OUT_YP = 0, OUT_YS = 8388608, OUT_CK = 16777216, OUT_CV = 20971520, OUT_SF = 25165824, OUT_SB = 26214400;


namespace pg8 {
#define PG8_LAS __attribute__((address_space(3)))
typedef unsigned short bf16_t;
typedef short bf16x8 __attribute__((ext_vector_type(8)));
typedef float f32x4 __attribute__((ext_vector_type(4)));
typedef unsigned u32x4 __attribute__((ext_vector_type(4)));
constexpr int BM = 256, BK = 64, HALF = 128, HTB = HALF * BK * 2  , STAGE_BYTES = 8 * HTB, NXCD = 8, WGM = 8;

__host__ __device__ __forceinline__ int lds_byte(int r, int c) { const int st = (r >> 4) * 2 + (c >> 5), rr = r & 15, cc = c & 31, ob = rr * 64 + cc * 2; return st * 1024 + (ob ^ (((ob >> 9) & 1) << 5)); }
__host__ __device__ __forceinline__ void stage_rc(int b, int& R, int& C) { const int st = b / 1024, sb = b % 1024, swz = sb ^ (((sb >> 9) & 1) << 5); R = (st >> 1) * 16 + swz / 64; C = (st & 1) * 32 + (swz % 64) / 2; }
__host__ __device__ __forceinline__ int perm32(int rho) { const int n = rho >> 4, i = rho & 15; return 8 * (i >> 2) + 4 * n + (i & 3); }

struct Unit { int pm, pn; };
struct Gemm { const bf16_t* A; const bf16_t* Bt; int M, N, K; };

struct StaticOrder {
    int nM, nN, nwg, G, c;
    __host__ __device__ void init(int M, int N, int G_, int c_) { nM = M / BM; nN = N / BM; nwg = nM * nN; G = G_; c = c_; }
    __host__ __device__ bool next(int i, Unit& u) const {
        const long L = (long)i * G + c; if (L >= nwg) return false;
        int wgid = (int)L; { const int q = nwg / NXCD, r = nwg % NXCD, xcd = wgid % NXCD, off = wgid / NXCD; wgid = (xcd < r ? xcd * (q + 1) : r * (q + 1) + (xcd - r) * q) + off; }
        const int nig = WGM * nN, gid = wgid / nig, fm = gid * WGM, gsz = (nM - fm) < WGM ? (nM - fm) : WGM;
        u.pm = fm + ((wgid % nig) % gsz); u.pn = (wgid % nig) / gsz; return true;
    }
    __device__ __forceinline__ void a_ready(const Unit&) const {}
    __device__ __forceinline__ void done(const Unit&) const {}
};

__device__ __forceinline__ unsigned cvt_pk_bf16(float lo, float hi) { unsigned r; asm volatile("v_cvt_pk_bf16_f32 %0, %1, %2" : "=v"(r) : "v"(lo), "v"(hi)); return r; }
typedef float f32x2 __attribute__((ext_vector_type(2)));
__device__ __forceinline__ f32x2 gelu_pk(f32x2 v) {
    const f32x2 av = __builtin_elementwise_abs(v), d = av * 0.2316418882f + 1.0f;
    f32x2 t; t.x = __builtin_amdgcn_rcpf(d.x); t.y = __builtin_amdgcn_rcpf(d.y);
    f32x2 q = t * 0.5307027145f + (-0.7265760135f); q = q * t + 0.7107068705f; q = q * t + (-0.142248368f); q = q * t + 0.127414796f; q = q * t;
    const f32x2 s = (v * v) * (-0.72134752044f);
    f32x2 e; e.x = __builtin_amdgcn_exp2f(s.x); e.y = __builtin_amdgcn_exp2f(s.y);
    const f32x2 m = v * (q * e), r = v - m;
    f32x2 o; o.x = v.x < 0.f ? m.x : r.x; o.y = v.y < 0.f ? m.y : r.y; return o;
}

template <int ACT  > struct EpiBf16 {
    static constexpr bool PERM = true, AFTER_DRAIN = false; static_assert(ACT == 0 || ACT == 1, "EpiBf16: ACT is 0 (none) or 1 (gelu_pk)");
    bf16_t* O; int ldc; const float* bias; int split_cols; size_t split_stride; float scale0;
    __device__ __forceinline__ void operator()(const f32x4 (&acc)[2][2][4][2], const Unit& u, int wr, int wc, int fr, int fq) const {
        const int row0 = u.pm * BM + wr * 64 + fr; int colt = u.pn * BM; bf16_t* base = O;
        float sc = 1.f; if (split_cols) { const int t = colt / split_cols; base += (size_t)t * split_stride; colt -= t * split_cols; if (t == 0) sc = scale0; }
        const int col0 = colt + wc * 32 + 8 * fq, bcol0 = u.pn * BM + wc * 32 + 8 * fq;
        f32x4 bv[2][2];
#pragma unroll
        for (int bj = 0; bj < 2; ++bj)
#pragma unroll
            for (int n = 0; n < 2; ++n) bv[bj][n] = bias ? *(const f32x4*)(bias + bcol0 + bj * HALF + 4 * n) : (f32x4){0.f, 0.f, 0.f, 0.f};
#pragma unroll
        for (int ai = 0; ai < 2; ++ai)
#pragma unroll
            for (int m = 0; m < 4; ++m) { bf16_t* rowp = base + (size_t)(row0 + ai * HALF + m * 16) * ldc + col0;
#pragma unroll
                for (int bj = 0; bj < 2; ++bj) { f32x4 v0 = acc[ai][bj][m][0] + bv[bj][0], v1 = acc[ai][bj][m][1] + bv[bj][1];
                    if (ACT == 1) { f32x2 a = gelu_pk((f32x2){v0[0], v0[1]}), b = gelu_pk((f32x2){v0[2], v0[3]}), c = gelu_pk((f32x2){v1[0], v1[1]}), d = gelu_pk((f32x2){v1[2], v1[3]});
                        v0 = (f32x4){a.x, a.y, b.x, b.y}; v1 = (f32x4){c.x, c.y, d.x, d.y}; }
                    v0 = v0 * sc; v1 = v1 * sc; u32x4 w; w.x = cvt_pk_bf16(v0[0], v0[1]); w.y = cvt_pk_bf16(v0[2], v0[3]); w.z = cvt_pk_bf16(v1[0], v1[1]); w.w = cvt_pk_bf16(v1[2], v1[3]);
                    *(u32x4*)(rowp + bj * HALF) = w; } }
    }
};

struct PanelStats {
    unsigned* xbuf;
    unsigned* cnt;
    unsigned* tmo;
    int ntn; float eps;
    unsigned code;
    __device__ __forceinline__ bool run(const f32x4 (&v)[2][2][4][2], const Unit& u, int wr, int wc, int fr, int fq, PG8_LAS unsigned char* lds, int wid, int lane) const {
        typedef float f32x2v __attribute__((ext_vector_type(2)));
        PG8_LAS f32x2v* P = (PG8_LAS f32x2v*)lds;
        PG8_LAS f32x2v* S = (PG8_LAS f32x2v*)(lds + 8192);
        PG8_LAS unsigned* flag = (PG8_LAS unsigned*)(lds + 8192 + 2048);
#pragma unroll
        for (int ai = 0; ai < 2; ++ai)
#pragma unroll
            for (int m = 0; m < 4; ++m) {
                float s = 0.f;
#pragma unroll
                for (int bj = 0; bj < 2; ++bj)
#pragma unroll
                    for (int n = 0; n < 2; ++n) { const f32x4 x = v[ai][bj][m][n]; s += (x[0] + x[1]) + (x[2] + x[3]); }
                s += __shfl_xor(s, 16); s += __shfl_xor(s, 32);
                const float mw = s * (1.0f / 64.0f); float q = 0.f;
#pragma unroll
                for (int bj = 0; bj < 2; ++bj)
#pragma unroll
                    for (int n = 0; n < 2; ++n) { const f32x4 d = v[ai][bj][m][n] - mw; q += (d[0] * d[0] + d[1] * d[1]) + (d[2] * d[2] + d[3] * d[3]); }
                q += __shfl_xor(q, 16); q += __shfl_xor(q, 32);
                if (fq == 0) P[(ai * HALF + wr * 64 + m * 16 + fr) * 4 + wc] = (f32x2v){mw, q};
            }
        asm volatile("s_waitcnt lgkmcnt(0)" ::: "memory"); __builtin_amdgcn_s_barrier(); asm volatile("" ::: "memory");
        const int row = wid * 32 + (lane & 31);
        if (lane < 32) {
            const f32x2v a = P[row * 4 + 0], b = P[row * 4 + 1], c = P[row * 4 + 2], d = P[row * 4 + 3];
            const float mt = (a.x + b.x + c.x + d.x) * 0.25f;
            const float da = a.x - mt, db = b.x - mt, dc = c.x - mt, dd = d.x - mt;
            const float m2 = (a.y + b.y) + (c.y + d.y) + 64.0f * ((da * da + db * db) + (dc * dc + dd * dd));
            unsigned long long* slot = (unsigned long long*)xbuf + ((size_t)(u.pm * BM + row) * 4 + u.pn);
            __hip_atomic_store(slot, ((unsigned long long)__float_as_uint(m2) << 32) | __float_as_uint(mt), __ATOMIC_RELAXED, __HIP_MEMORY_SCOPE_AGENT);
        }
        asm volatile("s_waitcnt vmcnt(0)" ::: "memory");
        if (lane == 0) __hip_atomic_fetch_add(cnt + 64 * u.pm, 1u, __ATOMIC_RELAXED, __HIP_MEMORY_SCOPE_AGENT);
        if (wid == 0) {
            bool dead = false; const unsigned long long t0 = __builtin_amdgcn_s_memrealtime(); const unsigned want = 8u * (unsigned)ntn;
            for (;;) {
                if ((unsigned)__builtin_amdgcn_readfirstlane(__hip_atomic_load(cnt + 64 * u.pm, __ATOMIC_RELAXED, __HIP_MEMORY_SCOPE_AGENT)) >= want) break;
                if (__builtin_amdgcn_s_memrealtime() - t0 > 2000000ull) {
                    if (lane == 0) { unsigned expect = 0u; __hip_atomic_compare_exchange_strong(tmo + 1, &expect, code | (unsigned)(u.pm & 0xff), __ATOMIC_RELAXED, __ATOMIC_RELAXED, __HIP_MEMORY_SCOPE_AGENT);
                                     __hip_atomic_store(tmo, 1u, __ATOMIC_RELAXED, __HIP_MEMORY_SCOPE_AGENT); }
                    dead = true; break; }
                __builtin_amdgcn_s_sleep(2);
            }
            __builtin_amdgcn_fence(__ATOMIC_ACQUIRE, "agent");
            if (lane == 0) flag[0] = dead ? 1u : 0u;
        }
        asm volatile("s_waitcnt vmcnt(0) lgkmcnt(0)" ::: "memory"); __builtin_amdgcn_s_barrier(); asm volatile("" ::: "memory");
        const bool bad = flag[0] != 0u;
        if (lane < 32) {
            const unsigned long long* slot = (const unsigned long long*)xbuf + (size_t)(u.pm * BM + row) * 4; float mt[4], m2[4]; float ms = 0.f;
#pragma unroll
            for (int t = 0; t < 4; ++t) { if (t < ntn) { const unsigned long long w = __hip_atomic_load(slot + t, __ATOMIC_RELAXED, __HIP_MEMORY_SCOPE_AGENT); mt[t] = __uint_as_float((unsigned)w); m2[t] = __uint_as_float((unsigned)(w >> 32)); } else { mt[t] = 0.f; m2[t] = 0.f; } ms += mt[t]; }
            const float mean = ms / (float)ntn; float q = 0.f;
#pragma unroll
            for (int t = 0; t < 4; ++t) if (t < ntn) { const float dm = mt[t] - mean; q += m2[t] + 256.0f * dm * dm; }
            S[row] = (f32x2v){mean, 1.0f / sqrtf(q / (256.0f * (float)ntn) + eps)};
        }
        asm volatile("s_waitcnt lgkmcnt(0)" ::: "memory"); __builtin_amdgcn_s_barrier(); asm volatile("" ::: "memory");
        return bad;
    }
};
struct EpiLnRes {
    static constexpr bool PERM = false, AFTER_DRAIN = true;
    const float* base; float* out; int ldc; const float* bias; PanelStats st; unsigned poison;
    __device__ __forceinline__ void fused(f32x4 (&acc)[2][2][4][2], const Unit& u, int wr, int wc, int fr, int fq, PG8_LAS unsigned char* lds, int wid, int lane) const {
        typedef float f32x2v __attribute__((ext_vector_type(2)));
        const PG8_LAS f32x2v* S = (const PG8_LAS f32x2v*)(lds + 8192);
        const int col0 = u.pn * BM + wc * 32 + 4 * fq;
#pragma unroll
        for (int bj = 0; bj < 2; ++bj)
#pragma unroll
            for (int n = 0; n < 2; ++n) { const f32x4 bv = bias ? *(const f32x4*)(bias + col0 + bj * HALF + n * 16) : (f32x4){0.f, 0.f, 0.f, 0.f};
#pragma unroll
                for (int ai = 0; ai < 2; ++ai)
#pragma unroll
                    for (int m = 0; m < 4; ++m) acc[ai][bj][m][n] += bv; }
        f32x4 pre[4][2][2];
#pragma unroll
        for (int m = 0; m < 4; ++m) { const size_t off = (size_t)(u.pm * BM + wr * 64 + m * 16 + fr) * ldc + col0;
#pragma unroll
            for (int bj = 0; bj < 2; ++bj)
#pragma unroll
                for (int n = 0; n < 2; ++n) pre[m][bj][n] = *(const f32x4*)(base + off + bj * HALF + n * 16); }
        const bool bad = st.run(acc, u, wr, wc, fr, fq, lds, wid, lane) || poison != 0u;
        const float qnan = __builtin_nanf("");
#pragma unroll
        for (int ai = 0; ai < 2; ++ai)
#pragma unroll
            for (int m = 0; m < 4; ++m) { const int r = ai * HALF + wr * 64 + m * 16 + fr; const f32x2v sr = S[r]; const size_t off = (size_t)(u.pm * BM + r) * ldc + col0;
#pragma unroll
                for (int bj = 0; bj < 2; ++bj)
#pragma unroll
                    for (int n = 0; n < 2; ++n) { const f32x4 bs = ai == 0 ? pre[m][bj][n] : *(const f32x4*)(base + off + bj * HALF + n * 16); f32x4 o = bs + (acc[ai][bj][m][n] - sr.x) * sr.y;
                        if (bad) o = (f32x4){qnan, qnan, qnan, qnan}; *(f32x4*)(out + off + bj * HALF + n * 16) = o; }
                if (m & 1) asm volatile("" ::: "memory"); }
    }
};
struct EpiLnResLn {
    static constexpr bool PERM = false, AFTER_DRAIN = true;
    const float* base; float* out; bf16_t* xn; int ldc; const float* bias; PanelStats st1, st2; unsigned poison;
    __device__ __forceinline__ void fused(f32x4 (&acc)[2][2][4][2], const Unit& u, int wr, int wc, int fr, int fq, PG8_LAS unsigned char* lds, int wid, int lane) const {
        typedef float f32x2v __attribute__((ext_vector_type(2))); typedef unsigned u32x2v __attribute__((ext_vector_type(2)));
        const PG8_LAS f32x2v* S = (const PG8_LAS f32x2v*)(lds + 8192);
        const int col0 = u.pn * BM + wc * 32 + 4 * fq;
#pragma unroll
        for (int bj = 0; bj < 2; ++bj)
#pragma unroll
            for (int n = 0; n < 2; ++n) { const f32x4 bv = bias ? *(const f32x4*)(bias + col0 + bj * HALF + n * 16) : (f32x4){0.f, 0.f, 0.f, 0.f};
#pragma unroll
                for (int ai = 0; ai < 2; ++ai)
#pragma unroll
                    for (int m = 0; m < 4; ++m) acc[ai][bj][m][n] += bv; }
        bool bad = st1.run(acc, u, wr, wc, fr, fq, lds, wid, lane) || poison != 0u;
        const float qnan = __builtin_nanf("");
#pragma unroll
        for (int ai = 0; ai < 2; ++ai)
#pragma unroll
            for (int m = 0; m < 4; ++m) { const int r = ai * HALF + wr * 64 + m * 16 + fr; const f32x2v sr = S[r]; const size_t off = (size_t)(u.pm * BM + r) * ldc + col0;
#pragma unroll
                for (int bj = 0; bj < 2; ++bj)
#pragma unroll
                    for (int n = 0; n < 2; ++n) { const f32x4 bs = *(const f32x4*)(base + off + bj * HALF + n * 16); acc[ai][bj][m][n] = bs + (acc[ai][bj][m][n] - sr.x) * sr.y; }
                asm volatile("" : "+v"(acc[ai][0][m][0]), "+v"(acc[ai][0][m][1]), "+v"(acc[ai][1][m][0]), "+v"(acc[ai][1][m][1]));
                if (m & 1) asm volatile("" ::: "memory"); }
        const bool bad1 = bad;
        bad = st2.run(acc, u, wr, wc, fr, fq, lds, wid, lane) || bad;
#pragma unroll
        for (int ai = 0; ai < 2; ++ai)
#pragma unroll
            for (int m = 0; m < 4; ++m) { const int r = ai * HALF + wr * 64 + m * 16 + fr; const f32x2v sr = S[r]; const size_t off = (size_t)(u.pm * BM + r) * ldc + col0;
#pragma unroll
                for (int bj = 0; bj < 2; ++bj)
#pragma unroll
                    for (int n = 0; n < 2; ++n) { const f32x4 x1 = acc[ai][bj][m][n]; *(f32x4*)(out + off + bj * HALF + n * 16) = bad1 ? (f32x4){qnan, qnan, qnan, qnan} : x1;
                        const f32x4 o = (x1 - sr.x) * sr.y; u32x2v w; w.x = cvt_pk_bf16(o[0], o[1]); w.y = cvt_pk_bf16(o[2], o[3]);
                        if (bad) { w.x = 0x7fc07fc0u; w.y = 0x7fc07fc0u; } *(u32x2v*)(xn + off + bj * HALF + n * 16) = w; }
                asm volatile("" ::: "memory"); }
    }
};

template <class Epi, class Sched, bool ALIGN_EPI = false, bool SP2 = false>
__device__ __forceinline__ void gemm_phase(PG8_LAS unsigned char* lds, const Gemm g, const Sched& S, const Epi& E) {
    int tid = threadIdx.x; asm volatile("" : "+v"(tid));
    const int wid = __builtin_amdgcn_readfirstlane(tid >> 6), lane = tid & 63, wr = wid >> 2, wc = wid & 3, fr = lane & 15, fq = lane >> 4;
    const int K = g.K, nt = K / BK;
    unsigned voffA[2], voffB[2];
#pragma unroll
    for (int i = 0; i < 2; ++i) { int R, C; stage_rc(tid * 16 + i * 8192, R, C); const int Rb = Epi::PERM ? ((R & ~31) + perm32(R & 31)) : R;
        voffA[i] = (unsigned)(R * K + C) * 2u; voffB[i] = (unsigned)(Rb * K + C) * 2u; }
    const size_t kstep = (size_t)(BK * 2);
    const size_t hstep = (size_t)HALF * K * 2;
    const size_t tstep = 2 * hstep;
    const unsigned ldsw = (unsigned)wid * 1024u;
    const int aoff = lds_byte(wr * 64 + fr, fq * 8), boff = lds_byte(wc * 32 + fr, fq * 8);
#define PG8_SA(b, h) (((b) * 2 + (h)) * HTB)
#define PG8_SB(b, h) ((4 + (b) * 2 + (h)) * HTB)
#define PG8_STAGE(bufoff, gbase, voff) do { _Pragma("unroll") for (int _i = 0; _i < 2; ++_i) \
        __builtin_amdgcn_global_load_lds((const unsigned*)((const char*)(gbase) + (voff)[_i]), (PG8_LAS unsigned*)(lds + (bufoff) + ldsw + _i * 8192), 16, 0, 0); } while (0)
#define PG8_LDA(dst, b, h) do { _Pragma("unroll") for (int m = 0; m < 4; ++m) _Pragma("unroll") for (int k = 0; k < 2; ++k) dst[m][k] = *(const PG8_LAS bf16x8*)(lds + PG8_SA(b, h) + aoff + m * 2048 + k * 1024); } while (0)
#define PG8_LDB(dst, b, h) do { _Pragma("unroll") for (int n = 0; n < 2; ++n) _Pragma("unroll") for (int k = 0; k < 2; ++k) dst[n][k] = *(const PG8_LAS bf16x8*)(lds + PG8_SB(b, h) + boff + n * 2048 + k * 1024); } while (0)
#define PG8_MMA(ai, bj, At, Bt) do { __builtin_amdgcn_s_setprio(1); _Pragma("unroll") for (int m = 0; m < 4; ++m) _Pragma("unroll") for (int n = 0; n < 2; ++n) _Pragma("unroll") for (int k = 0; k < 2; ++k) \
        acc[ai][bj][m][n] = __builtin_amdgcn_mfma_f32_16x16x32_bf16(Bt[n][k], At[m][k], acc[ai][bj][m][n], 0, 0, 0); __builtin_amdgcn_s_setprio(0); } while (0)
#define PG8_WAIT_V(n) asm volatile("s_waitcnt vmcnt(" #n ")" ::: "memory")
#define PG8_WAIT_L(n) asm volatile("s_waitcnt lgkmcnt(" #n ")" ::: "memory")
#define PG8_BAR __builtin_amdgcn_s_barrier()
#define PG8_SCHED __builtin_amdgcn_sched_barrier(0)
    Unit cur, nxt; int ui = 0;
    if (!S.next(0, cur)) return;
    f32x4 acc[2][2][4][2];
#pragma unroll
    for (int a = 0; a < 2; ++a)
#pragma unroll
        for (int b = 0; b < 2; ++b)
#pragma unroll
            for (int m = 0; m < 4; ++m)
#pragma unroll
                for (int n = 0; n < 2; ++n) acc[a][b][m][n] = (f32x4){0.f, 0.f, 0.f, 0.f};
    bf16x8 At[4][2], B0[2][2], B1[2][2];
    const char* cA = (const char*)g.A + (size_t)cur.pm * tstep; const char* cB = (const char*)g.Bt + (size_t)cur.pn * tstep;
    S.a_ready(cur);
    if constexpr (SP2) {
        PG8_STAGE(PG8_SB(0, 0), cB, voffB); PG8_STAGE(PG8_SB(0, 1), cB + hstep, voffB); PG8_STAGE(PG8_SA(0, 0), cA, voffA); PG8_STAGE(PG8_SA(0, 1), cA + hstep, voffA);
        if (wr == 1) PG8_BAR;
        PG8_WAIT_V(2); PG8_BAR;
        PG8_STAGE(PG8_SB(1, 0), cB + kstep, voffB); PG8_STAGE(PG8_SA(1, 0), cA + kstep, voffA); PG8_STAGE(PG8_SB(1, 1), cB + hstep + kstep, voffB);
        PG8_WAIT_V(6); PG8_BAR;
    } else {
        PG8_STAGE(PG8_SB(0, 0), cB, voffB); PG8_STAGE(PG8_SA(0, 0), cA, voffA); PG8_STAGE(PG8_SB(0, 1), cB + hstep, voffB); PG8_STAGE(PG8_SA(0, 1), cA + hstep, voffA);
        if (wr == 1) PG8_BAR;
        PG8_WAIT_V(4); PG8_BAR;
        PG8_STAGE(PG8_SB(1, 0), cB + kstep, voffB); PG8_STAGE(PG8_SA(1, 0), cA + kstep, voffA); PG8_STAGE(PG8_SB(1, 1), cB + hstep + kstep, voffB);
        PG8_WAIT_V(6); PG8_BAR;
    }
    for (;;) {
        const bool has_next = S.next(ui + 1, nxt);
        const char* nA = has_next ? (const char*)g.A + (size_t)nxt.pm * tstep : cA; const char* nB = has_next ? (const char*)g.Bt + (size_t)nxt.pn * tstep : cB;
        for (int t = 0; t < nt; t += 2) {
            const bool last = (t == nt - 2);
            const char* a1 = cA + (size_t)(t + 1) * kstep;
            const char* a2 = last ? nA : cA + (size_t)(t + 2) * kstep; const char* b2 = last ? nB : cB + (size_t)(t + 2) * kstep;
            const char* a3 = a2 + kstep; const char* b3 = b2 + kstep;
            if (last && has_next) S.a_ready(nxt);
            if constexpr (SP2) {
            PG8_LDB(B0, 0, 0); PG8_LDB(B1, 0, 1); PG8_SCHED; PG8_LDA(At, 0, 0); PG8_STAGE(PG8_SA(1, 1), a1 + hstep, voffA);
            PG8_WAIT_V(8); PG8_WAIT_L(0); PG8_BAR; PG8_MMA(0, 0, At, B0); PG8_MMA(0, 1, At, B1); PG8_BAR; PG8_SCHED;
            PG8_LDA(At, 0, 1); PG8_STAGE(PG8_SB(0, 0), b2, voffB); PG8_STAGE(PG8_SB(0, 1), b2 + hstep, voffB); PG8_STAGE(PG8_SA(0, 0), a2, voffA);
            PG8_WAIT_V(8); PG8_WAIT_L(0); PG8_BAR; PG8_MMA(1, 0, At, B0); PG8_MMA(1, 1, At, B1); PG8_BAR; PG8_SCHED;
            PG8_LDB(B0, 1, 0); PG8_LDB(B1, 1, 1); PG8_SCHED; PG8_LDA(At, 1, 0); PG8_STAGE(PG8_SA(0, 1), a2 + hstep, voffA);
            PG8_WAIT_V(8); PG8_WAIT_L(0); PG8_BAR; PG8_MMA(0, 0, At, B0); PG8_MMA(0, 1, At, B1); PG8_BAR; PG8_SCHED;
            PG8_LDA(At, 1, 1); PG8_STAGE(PG8_SB(1, 0), b3, voffB); PG8_STAGE(PG8_SB(1, 1), b3 + hstep, voffB); PG8_STAGE(PG8_SA(1, 0), a3, voffA);
            PG8_WAIT_V(8); PG8_WAIT_L(0); PG8_BAR; PG8_MMA(1, 0, At, B0); PG8_MMA(1, 1, At, B1); PG8_BAR; PG8_SCHED;
            } else {
            PG8_LDB(B0, 0, 0); PG8_SCHED; PG8_LDA(At, 0, 0); PG8_STAGE(PG8_SA(1, 1), a1 + hstep, voffA);
            PG8_WAIT_L(8); PG8_BAR; PG8_WAIT_L(0); PG8_MMA(0, 0, At, B0); PG8_BAR; PG8_SCHED;
            PG8_LDB(B1, 0, 1); PG8_STAGE(PG8_SB(0, 0), b2, voffB);
            PG8_BAR; PG8_WAIT_L(0); PG8_MMA(0, 1, At, B1); PG8_BAR;
            PG8_LDA(At, 0, 1); PG8_STAGE(PG8_SA(0, 0), a2, voffA);
            PG8_BAR; PG8_WAIT_L(0); PG8_MMA(1, 0, At, B0); PG8_BAR; PG8_SCHED;
            PG8_STAGE(PG8_SB(0, 1), b2 + hstep, voffB);
            PG8_WAIT_V(6); PG8_BAR; PG8_MMA(1, 1, At, B1); PG8_BAR;
            PG8_LDB(B0, 1, 0); PG8_SCHED; PG8_LDA(At, 1, 0); PG8_STAGE(PG8_SA(0, 1), a2 + hstep, voffA);
            PG8_WAIT_L(8); PG8_BAR; PG8_WAIT_L(0); PG8_MMA(0, 0, At, B0); PG8_BAR; PG8_SCHED;
            PG8_LDB(B1, 1, 1); PG8_STAGE(PG8_SB(1, 0), b3, voffB);
            PG8_BAR; PG8_WAIT_L(0); PG8_MMA(0, 1, At, B1); PG8_BAR;
            PG8_LDA(At, 1, 1); PG8_STAGE(PG8_SA(1, 0), a3, voffA);
            PG8_BAR; PG8_WAIT_L(0); PG8_MMA(1, 0, At, B0); PG8_BAR; PG8_SCHED;
            PG8_STAGE(PG8_SB(1, 1), b3 + hstep, voffB);
            PG8_WAIT_V(6); PG8_BAR; PG8_MMA(1, 1, At, B1); PG8_BAR;
            }
        }
        if constexpr (ALIGN_EPI) { if (wr == 0) PG8_BAR; }
        if constexpr (!Epi::AFTER_DRAIN) { E(acc, cur, wr, wc, fr, fq); S.done(cur); }
        if (!has_next) break;
#pragma unroll
        for (int a = 0; a < 2; ++a)
#pragma unroll
            for (int b = 0; b < 2; ++b)
#pragma unroll
                for (int m = 0; m < 4; ++m)
#pragma unroll
                    for (int n = 0; n < 2; ++n) acc[a][b][m][n] = (f32x4){0.f, 0.f, 0.f, 0.f};
        cur = nxt; cA = nA; cB = nB; ++ui;
        if constexpr (ALIGN_EPI) { if (wr == 1) PG8_BAR; }
    }
    PG8_WAIT_V(0);
    if constexpr (!ALIGN_EPI) { if (wr == 0) PG8_BAR; }
    PG8_BAR;
    if constexpr (Epi::AFTER_DRAIN) { E.fused(acc, cur, wr, wc, fr, fq, lds, wid, lane); S.done(cur); }
#undef PG8_SA
#undef PG8_SB
#undef PG8_STAGE
#undef PG8_LDA
#undef PG8_LDB
#undef PG8_MMA
#undef PG8_WAIT_V
#undef PG8_WAIT_L
#undef PG8_BAR
#undef PG8_SCHED
}
}

template <class F> struct EpiF4 {
    static constexpr bool PERM = false, AFTER_DRAIN = false; F f;
    __device__ __forceinline__ void operator()(const pg8::f32x4 (&acc)[2][2][4][2], const pg8::Unit& u, int wr, int wc, int fr, int fq) const {
        const int row0 = u.pm * 256 + wr * 64 + fr, col0 = u.pn * 256 + wc * 32 + 4 * fq;
#pragma unroll
        for (int ai = 0; ai < 2; ++ai)
#pragma unroll
            for (int m = 0; m < 4; ++m)
#pragma unroll
                for (int bj = 0; bj < 2; ++bj) f(row0 + ai * 128 + m * 16, col0 + bj * 128, acc[ai][bj][m][0], acc[ai][bj][m][1]);
    }
};
typedef unsigned short bf16;
__device__ __forceinline__ unsigned f2bf(float f) { unsigned u = __builtin_bit_cast(unsigned, f); return (u + 0x7fffu + ((u >> 16) & 1u)) >> 16; }
__device__ __forceinline__ unsigned pk2(float lo, float hi) { return f2bf(lo) | (f2bf(hi) << 16); }
__device__ __forceinline__ float bf2f(unsigned short h) { return __uint_as_float((unsigned)h << 16); }
__device__ __forceinline__ float bflo(unsigned w) { return __uint_as_float(w << 16); }
__device__ __forceinline__ float bfhi(unsigned w) { return __uint_as_float(w & 0xffff0000u); }
typedef unsigned u32x2 __attribute__((ext_vector_type(2)));
typedef unsigned u32x4 __attribute__((ext_vector_type(4)));

__device__ __forceinline__ void p0_transpose_item(const float* W, int K, int N, bf16* WT, float* scr, int item, int lane) {
    const int nblk = N / 32, kb = item / nblk, nb = item % nblk, k0 = 64 * kb, n0 = 32 * nb;
#pragma unroll 8
    for (int i = 0; i < 32; ++i) { const int kk = 2 * i + (lane >> 5); scr[kk * 33 + (lane & 31)] = W[(size_t)(k0 + kk) * N + n0 + (lane & 31)]; }
    asm volatile("s_waitcnt lgkmcnt(0)" ::: "memory");
    const int c = lane & 7;
#pragma unroll
    for (int j = 0; j < 4; ++j) { const int n = (lane >> 3) + 8 * j; const float* sp = scr + (8 * c) * 33 + n;
        u32x4 o; o.x = pk2(sp[0 * 33], sp[1 * 33]); o.y = pk2(sp[2 * 33], sp[3 * 33]); o.z = pk2(sp[4 * 33], sp[5 * 33]); o.w = pk2(sp[6 * 33], sp[7 * 33]);
        *(u32x4*)(WT + (size_t)(n0 + n) * K + k0 + 8 * c) = o; }
    asm volatile("s_waitcnt lgkmcnt(0)" ::: "memory");
}
__device__ __forceinline__ void phase_prologue(const Args& a, float* lds) {
    const int tid = TID, bid = BID, gdim = GDIM;
    float* MOD = (float*)(a.ws + WS_MOD);
    {
        for (int i = tid; i < 3 * D; i += NT) { const int g = i >> 10, k = i & 1023; const float c = (g == 0) ? a.in[I_CCTX][k] : a.in[I_C][(g - 1) * D + k]; lds[i] = siluf(c); }
        __syncthreads();
    }
    for (int it = bid; it < NLAYER * 192; it += gdim) {
        const int l = it / 192, cb = it % 192;
        const float* sl = lds;
        const int cl = tid & 31, ks = tid >> 5;
        float a0 = 0.f, a1 = 0.f, a2 = 0.f;
        const float* w = a.in[I_WADA] + ((size_t)l * D + ks * 64) * 6144 + cb * 32 + cl;
#pragma unroll 16
        for (int k = 0; k < 64; ++k) { const float wv = w[(size_t)k * 6144]; const int kk = ks * 64 + k; a0 += sl[kk] * wv; a1 += sl[D + kk] * wv; a2 += sl[2 * D + kk] * wv; }
        float* red = lds + 3 * D;
        red[(ks * 3 + 0) * 32 + cl] = a0; red[(ks * 3 + 1) * 32 + cl] = a1; red[(ks * 3 + 2) * 32 + cl] = a2;
        __syncthreads();
        if (tid < 96) { const int g = tid >> 5, c = tid & 31; float sm = a.in[I_BADA][l * 6144 + cb * 32 + c];
#pragma unroll
            for (int q = 0; q < 16; ++q) sm += red[(q * 3 + g) * 32 + c];
            MOD[(size_t)(l * 3 + g) * 6144 + cb * 32 + c] = sm; }
        __syncthreads();
    }
    {
        const int lane = tid & 63, gw = bid * NWAVES + (tid >> 6), ngw = gdim * NWAVES;
        float* scr = lds + (tid >> 6) * 4096;
        constexpr int I_IN = 16 * 57, I_SQ = 16 * 32, PER_L = I_IN + 2 * I_SQ;
        for (int it = gw; it < NLAYER * PER_L; it += ngw) {
            const int l = it / PER_L; int r = it % PER_L;
            if (r < I_IN) { p0_transpose_item(a.in[I_WIN] + (size_t)l * D * INW, D, INW, (bf16*)(a.ws + WS_WIN_T) + (size_t)l * 2048 * D, scr, r, lane); continue; } r -= I_IN;
            if (r < I_SQ) { p0_transpose_item(a.in[I_WOUT] + (size_t)l * D * D, D, D, (bf16*)(a.ws + WS_WOUT_T) + (size_t)l * D * D, scr, r, lane); continue; } r -= I_SQ;
            p0_transpose_item(a.in[I_WQ] + (size_t)l * D * D, D, D, (bf16*)(a.ws + WS_WQ_T) + (size_t)l * D * D, scr, r, lane);
        }
        for (int i = bid * NT + tid; i < NLAYER * 28672; i += gdim * NT) { const int l = i / 28672, r = i % 28672;
            ((u32x4*)((bf16*)(a.ws + WS_WIN_T) + ((size_t)l * 2048 + INW) * D))[r] = (u32x4){0u, 0u, 0u, 0u}; }
    }
    {
        float* rt = (float*)(a.ws + WS_ROPE);
        for (int i = bid * NT + tid; i < 64 * 16; i += gdim * NT) { float sn, cs; sincosf((float)(i >> 4) * exp2f(-(float)(i & 15) * 0.83048202372184058696f), &sn, &cs); rt[2 * i] = cs; rt[2 * i + 1] = sn; }
        const f32x4* sk = (const f32x4*)a.in[I_SUBK]; u32x2* skb = (u32x2*)(a.ws + WS_SKB);
        for (int i = bid * NT + tid; i < NLAYER * 16 * 128 * 64 / 4; i += gdim * NT) { const f32x4 v = sk[i]; skb[i] = (u32x2){pk2(v.x, v.y), pk2(v.z, v.w)}; }
    }
}

__device__ __forceinline__ void phase_cvt_tables(const Args& a, int l) {
    const int tid = TID, bid = BID, gdim = GDIM;
    {
        const int lane = tid & 63, gw = bid * NWAVES + (tid >> 6), ngw = gdim * NWAVES;
        unsigned char* u8 = a.ws + WS_U8; unsigned char* v8 = a.ws + WS_V8; float* suv = (float*)(a.ws + WS_SUV);
        for (int row = l * 16384 + gw; row < (l + 1) * 16384; row += ngw) {
#pragma unroll
            for (int tb = 0; tb < 2; ++tb) {
                const float* src = (tb ? a.in[I_PV] : a.in[I_PU]) + (size_t)row * D + 16 * lane;
                f32x4 x[4]; float am = 0.f;
#pragma unroll
                for (int q = 0; q < 4; ++q) { x[q] = *(const f32x4*)(src + 4 * q); am = fmaxf(am, fmaxf(fmaxf(fabsf(x[q].x), fabsf(x[q].y)), fmaxf(fabsf(x[q].z), fabsf(x[q].w)))); }
                am = wave_max_u(am);
                const float inv = am > 0.f ? 448.f / am : 0.f;
                u32x4 o;
#pragma unroll
                for (int q = 0; q < 4; ++q) { int p = __builtin_amdgcn_cvt_pk_fp8_f32(x[q].x * inv, x[q].y * inv, 0, false); p = __builtin_amdgcn_cvt_pk_fp8_f32(x[q].z * inv, x[q].w * inv, p, true); o[q] = (unsigned)p; }
                *(u32x4*)((tb ? v8 : u8) + (size_t)row * D + 16 * lane) = o;
                if (lane == 0) suv[(size_t)row * 2 + tb] = am * (1.f / 448.f);
            }
        }
    }
}

__device__ __forceinline__ void phase_norm(const float* X, const float* X2  , const float* gain, const float* modl, int sh_off, int sc_off, bf16* H) {
    const int tid = TID, bid = BID, gdim = GDIM, lane = tid & 63, gw = bid * NWAVES + (tid >> 6), ngw = gdim * NWAVES;
    f32x4 nx[4];
    { const int t = min(gw, NTOK - 1); const f32x4* xr = (const f32x4*)((X2 && t >= NCTX) ? X2 + (size_t)(t - NCTX) * D : X + (size_t)t * D) + lane;
#pragma unroll
      for (int j = 0; j < 4; ++j) nx[j] = xr[64 * j]; }
    for (int t = gw; t < NTOK; t += ngw) {
        f32x4 v[4]; float ss = 0.f;
#pragma unroll
        for (int j = 0; j < 4; ++j) v[j] = nx[j];
        { const int tn = min(t + ngw, NTOK - 1); const f32x4* xr = (const f32x4*)((X2 && tn >= NCTX) ? X2 + (size_t)(tn - NCTX) * D : X + (size_t)tn * D) + lane;
#pragma unroll
          for (int j = 0; j < 4; ++j) nx[j] = xr[64 * j]; }
#pragma unroll
        for (int j = 0; j < 4; ++j) ss += v[j].x * v[j].x + v[j].y * v[j].y + v[j].z * v[j].z + v[j].w * v[j].w;
        ss = wave_sum_u(ss);
        const float r = 1.0f / sqrtf(ss * (1.f / D) + EPS);
        const float* m = modl + grp_of(t) * 6144;
        u32x2* hr = (u32x2*)(H + (size_t)t * D) + lane;
#pragma unroll
        for (int j = 0; j < 4; ++j) { const int col = 4 * (lane + 64 * j);
            const f32x4 g = *(const f32x4*)(gain + col), sc = *(const f32x4*)(m + sc_off + col), sh = *(const f32x4*)(m + sh_off + col);
            const f32x4 o = v[j] * r * g * (sc + 1.0f) + sh;
            hr[64 * j] = (u32x2){pk2(o.x, o.y), pk2(o.z, o.w)}; }
    }
}

struct FInProj { bf16* P; float* out; int l; const float* rope;
    __device__ __forceinline__ void operator()(int row, int col, const pg8::f32x4& v0, const pg8::f32x4& v1) const {
        if (col >= INW) return;
        f32x4 a = {v0[0], v0[1], v0[2], v0[3]}, b = {v1[0], v1[1], v1[2], v1[3]};
        if (row < NCTX && col >= C_AK) { const int bt = row >> 8, tt = row & 255, c = col - C_AK;
            const size_t base = ((size_t)(bt * NLAYER + l) * 256 + tt) * 128;
            float* o = (c < 128) ? (out + OUT_CK + base + c) : (out + OUT_CV + base + c - 128);
            *(f32x4*)o = a; *(f32x4*)(o + 16) = b; }
        if (col >= C_AQ && col < C_AV) {
            if (row >= NCTX) { const int tl = (row - NCTX) & 4095, half = ((col - C_AQ) >> 5) & 1, pos = half ? (tl & 63) : (tl >> 6), f0 = col & 15;
                const float* rt = rope + (pos * 16 + f0) * 2;
                { const f32x4 t = *(const f32x4*)rt; const float x1 = a.x, x2 = b.x, y1 = a.y, y2 = b.y;
                  a.x = x1 * t.x - x2 * t.y; b.x = x1 * t.y + x2 * t.x; a.y = y1 * t.z - y2 * t.w; b.y = y1 * t.w + y2 * t.z; }
                { const f32x4 t = *(const f32x4*)(rt + 4); const float x1 = a.z, x2 = b.z, y1 = a.w, y2 = b.w;
                  a.z = x1 * t.x - x2 * t.y; b.z = x1 * t.y + x2 * t.x; a.w = y1 * t.z - y2 * t.w; b.w = y1 * t.w + y2 * t.z; } }
            if (col < C_AK) { a = a * 0.18033688011112042f; b = b * 0.18033688011112042f; } }
        bf16* p = P + (size_t)row * INW + col;
        *(u32x2*)p = (u32x2){pk2(a.x, a.y), pk2(a.z, a.w)}; *(u32x2*)(p + 16) = (u32x2){pk2(b.x, b.y), pk2(b.z, b.w)};
    } };
struct FResid { float* X; const float* b0; const float* b1; const float* modl; int gate_off;
    __device__ __forceinline__ void operator()(int row, int col, const pg8::f32x4& v0, const pg8::f32x4& v1) const {
        const float* g = modl + grp_of(row) * 6144 + gate_off + col; float* xp = X + (size_t)row * D + col;
        const float* bp = (row < NCTX ? b0 + (size_t)row * D : b1 + (size_t)(row - NCTX) * D) + col;
        *(f32x4*)xp = *(const f32x4*)bp + *(const f32x4*)g * (f32x4){v0[0], v0[1], v0[2], v0[3]};
        *(f32x4*)(xp + 16) = *(const f32x4*)(bp + 16) + *(const f32x4*)(g + 16) * (f32x4){v1[0], v1[1], v1[2], v1[3]}; } };
struct FStore { bf16* Q;
    __device__ __forceinline__ void operator()(int row, int col, const pg8::f32x4& v0, const pg8::f32x4& v1) const {
        bf16* q = Q + ((size_t)(col >> 6) * NTOK + row) * 64 + (col & 63);
        *(u32x2*)q = (u32x2){pk2(v0[0], v0[1]), pk2(v0[2], v0[3])}; *(u32x2*)(q + 16) = (u32x2){pk2(v1[0], v1[1]), pk2(v1[2], v1[3])}; } };

__device__ __forceinline__ void phase_mixprep(const Args& a, int l, float* lds) {
    const int tid = TID, bid = BID, gdim = GDIM;
    const bf16* P = (const bf16*)(a.ws + WS_P); bf16* MIX = (bf16*)(a.ws + WS_MIX);
    float* XP = lds; float* DF = lds + 47 * 256;
    for (int tile = bid; tile < NTOK / 32; tile += gdim) {
        const int t0 = tile * 32;
        int s0, T; if (t0 < NCTX) { s0 = t0 & ~255; T = 256; } else { s0 = NCTX + ((t0 - NCTX) & ~4095); T = 4096; }
        { u32x2 wv[6];
#pragma unroll
          for (int it = 0; it < 6; ++it) { const int i = min(tid + it * NT, 47 * 64 - 1), rr = i >> 6, c4 = (i & 63) * 4, t = min(max(t0 - 8 + rr, s0), s0 + T - 1);
              wv[it] = *(const u32x2*)(P + (size_t)t * INW + c4); }
#pragma unroll
          for (int it = 0; it < 6; ++it) { const int i = tid + it * NT, rr = i >> 6, c4 = (i & 63) * 4, t = t0 - 8 + rr;
              if (i < 47 * 64) { const bool in = t >= s0 && t < s0 + T; const u32x2 w = wv[it];
                  *(f32x4*)&XP[rr * 256 + c4] = in ? (f32x4){bflo(w.x), bfhi(w.x), bflo(w.y), bfhi(w.y)} : (f32x4){0.f, 0.f, 0.f, 0.f}; } } }
        __syncthreads();
        if (tid < 256) { float run = 0.f;
#pragma unroll 8
            for (int rr = 0; rr < 47; ++rr) { run += XP[rr * 256 + tid]; XP[rr * 256 + tid] = run; } }
        __syncthreads();
        { const int ch = tid & 255, g = ch >> 6, win = 2 << g, left = win / 2, right = win - 1 - left;
          for (int tt = (tid >> 8) * 16; tt < (tid >> 8) * 16 + 16; ++tt) { const int tq = t0 + tt - s0;
              const int lo = max(tq - left, 0), hi = min(tq + right + 1, T), rlo = lo - tq + tt + 8, rhi = hi - tq + tt + 8;
              const float sum = XP[(rhi - 1) * 256 + ch] - (rlo > 0 ? XP[(rlo - 1) * 256 + ch] : 0.f);
              DF[tt * 256 + ch] = sum / (float)(hi - lo) - (XP[(tt + 8) * 256 + ch] - XP[(tt + 7) * 256 + ch]); } }
        __syncthreads();
        { const int tg = tid >> 6, og = tid & 63, g = og >> 4, oc = (og & 15) * 4;
          const float* w = a.in[I_POOLW] + (size_t)((l * 4 + g) * 64) * 64 + oc;
          f32x4 acc[4];
#pragma unroll
          for (int i = 0; i < 4; ++i) acc[i] = (f32x4){0.f, 0.f, 0.f, 0.f};
#pragma unroll 2
          for (int c = 0; c < 64; c += 4) {
              const f32x4 w0 = *(const f32x4*)(w + (c + 0) * 64), w1 = *(const f32x4*)(w + (c + 1) * 64), w2 = *(const f32x4*)(w + (c + 2) * 64), w3 = *(const f32x4*)(w + (c + 3) * 64);
#pragma unroll
              for (int i = 0; i < 4; ++i) { const f32x4 d = *(const f32x4*)&DF[(tg * 4 + i) * 256 + g * 64 + c]; acc[i] += w0 * d.x + w1 * d.y + w2 * d.z + w3 * d.w; } }
          const f32x4 sc = *(const f32x4*)(a.in[I_POOLS] + l * 256 + g * 64 + oc);
#pragma unroll
          for (int i = 0; i < 4; ++i) { const f32x4 y = acc[i] * sc; *(u32x2*)(MIX + (size_t)(t0 + tg * 4 + i) * D + g * 64 + oc) = (u32x2){pk2(y.x, y.y), pk2(y.z, y.w)}; } }
        __syncthreads();
    }
}

typedef short bf16x8 __attribute__((ext_vector_type(8)));
typedef float f32x16 __attribute__((ext_vector_type(16)));
__device__ __forceinline__ int at_vpos(int kk) { const int s = kk >> 4, rem = kk & 15; return 16 * s + 8 * ((rem >> 2) & 1) + (((rem >> 3) << 2) | (rem & 3)); }
__device__ __forceinline__ bf16x8 at_pack_step(const f32x16& x, int s) {
    u32x4 p;
    asm volatile("v_cvt_pk_bf16_f32 %0, %4, %5\n\tv_cvt_pk_bf16_f32 %1, %6, %7\n\tv_cvt_pk_bf16_f32 %2, %8, %9\n\tv_cvt_pk_bf16_f32 %3, %10, %11\n\ts_nop 1"
                 : "=&v"(p[0]), "=&v"(p[1]), "=&v"(p[2]), "=&v"(p[3])
                 : "v"(x[8 * s]), "v"(x[8 * s + 1]), "v"(x[8 * s + 2]), "v"(x[8 * s + 3]), "v"(x[8 * s + 4]), "v"(x[8 * s + 5]), "v"(x[8 * s + 6]), "v"(x[8 * s + 7]));
    return __builtin_bit_cast(bf16x8, p);
}
constexpr int GB_QF = 0, GB_QB = 5120, GB_KF = 10240, GB_KB = 15360, GB_VT = 20480, GB_KFT = 29696, GB_KBT = 34304, GB_SFT = 38912, GB_SBT = 44032, GB_DEC = 49152, GB_SSQ = 49408, GB_QROW = 80, GB_VROW = 144;
constexpr int GB_GROUP = 51200;
template <bool LOCAL>
__device__ __forceinline__ void gla_prep(const Args& a, int l, int cg, int h, unsigned char* lds, const unsigned char* gwl, int tg) {
    const bf16* P = (const bf16*)(a.ws + WS_P);
    const int lane = tg & 63, wg = tg >> 6;
    const bf16* pr = P + (size_t)(cg * 64 + lane) * INW;
    float zf[16], zb[16];
    { const u32x4 a0 = *(const u32x4*)(pr + C_ZF), a1 = *(const u32x4*)(pr + C_ZF + 8), b0 = *(const u32x4*)(pr + C_ZB), b1 = *(const u32x4*)(pr + C_ZB + 8);
#pragma unroll
      for (int q = 0; q < 4; ++q) { zf[2 * q] = bflo(a0[q]); zf[2 * q + 1] = bfhi(a0[q]); zf[8 + 2 * q] = bflo(a1[q]); zf[8 + 2 * q + 1] = bfhi(a1[q]);
                                    zb[2 * q] = bflo(b0[q]); zb[2 * q + 1] = bfhi(b0[q]); zb[8 + 2 * q] = bflo(b1[q]); zb[8 + 2 * q + 1] = bfhi(b1[q]); } }
    const float* gw = (const float*)gwl;
    const int spos = (lane & ~31) + at_vpos(lane & 31);
#pragma unroll 2
    for (int i = 0; i < 8; ++i) {
        const int dk = 8 * wg + i, col = h * 32 + dk;
        float lf = gw[4096 + col], lb = gw[4224 + col];
#pragma unroll
        for (int r = 0; r < 16; ++r) { lf += zf[r] * gw[r * 128 + col]; lb += zb[r] * gw[2048 + r * 128 + col]; }
        const float bf = wave_prefix_incl(log_sigmoid_fast(lf) * (1.f / 16.f), lane), bb = wave_suffix_incl(log_sigmoid_fast(lb) * (1.f / 16.f), lane);
        const float q = bf2f(pr[C_GQ + col]) * 0.17677669529663687f, k = bf2f(pr[C_GK + col]);
        const unsigned short kf = (unsigned short)f2bf(k * __expf(-bf)), kb = (unsigned short)f2bf(k * __expf(-bb));
        if (LOCAL) { *(unsigned short*)(lds + GB_KFT + dk * GB_VROW + spos * 2) = kf; *(unsigned short*)(lds + GB_KBT + dk * GB_VROW + spos * 2) = kb; }
        else { *(unsigned short*)(lds + GB_QF + lane * GB_QROW + dk * 2) = (unsigned short)f2bf(q * __expf(bf)); *(unsigned short*)(lds + GB_QB + lane * GB_QROW + dk * 2) = (unsigned short)f2bf(q * __expf(bb));
               *(unsigned short*)(lds + GB_KF + lane * GB_QROW + dk * 2) = kf; *(unsigned short*)(lds + GB_KB + lane * GB_QROW + dk * 2) = kb; }
        if (LOCAL) { if (lane == 63) ((float*)(lds + GB_DEC))[dk] = __expf(bf); if (lane == 0) ((float*)(lds + GB_DEC))[32 + dk] = __expf(bb); }
    }
#pragma unroll
    for (int it = 0; it < 2; ++it) { const int r = (tg >> 3) + 32 * it, c = (tg & 7) * 8; const u32x4 v = *(const u32x4*)(P + (size_t)(cg * 64 + r) * INW + C_GV + h * 64 + c);
      const int pos0 = (r & ~31) + at_vpos(r & 31), pos = (((pos0 >> 3) ^ (tg & 7)) << 3) | (pos0 & 7);
      unsigned short* vt = (unsigned short*)(lds + GB_VT + c * GB_VROW + pos * 2);
      vt[0 * (GB_VROW / 2)] = (unsigned short)v.x; vt[1 * (GB_VROW / 2)] = (unsigned short)(v.x >> 16); vt[2 * (GB_VROW / 2)] = (unsigned short)v.y; vt[3 * (GB_VROW / 2)] = (unsigned short)(v.y >> 16);
      vt[4 * (GB_VROW / 2)] = (unsigned short)v.z; vt[5 * (GB_VROW / 2)] = (unsigned short)(v.z >> 16); vt[6 * (GB_VROW / 2)] = (unsigned short)v.w; vt[7 * (GB_VROW / 2)] = (unsigned short)(v.w >> 16); }
}
constexpr int GB_GW = 2 * GB_GROUP;
__device__ __forceinline__ void gla_stage_gates(const Args& a, int l, unsigned char* lds0, int tid) {
    float* gw = (float*)(lds0 + GB_GW);
    const float* wf = a.in[I_GWF] + (size_t)l * 2048; const float* wb = a.in[I_GWB] + (size_t)l * 2048;
    *(f32x4*)(gw + 4 * tid) = *(const f32x4*)(wf + 4 * tid); *(f32x4*)(gw + 2048 + 4 * tid) = *(const f32x4*)(wb + 4 * tid);
    if (tid < 128) { gw[4096 + tid] = a.in[I_GBF][l * 128 + tid]; gw[4224 + tid] = a.in[I_GBB][l * 128 + tid]; }
    __syncthreads();
}
__device__ __forceinline__ void phase_gla_local(const Args& a, int l, unsigned char* lds0) {
    const int tid = TID, bid = BID, gdim = GDIM, lane = tid & 63, w = __builtin_amdgcn_readfirstlane(tid >> 6), r = lane & 31, hh = lane >> 5, grp = w >> 2, wg = w & 3, tg = tid & 255;
    unsigned char* lds = lds0 + grp * GB_GROUP;
    float* DS = (float*)(a.ws + WS_DS); float* DEC = (float*)(a.ws + WS_DEC);
    gla_stage_gates(a, l, lds0, tid);
    for (int u0 = 2 * bid; u0 < 1024; u0 += 2 * gdim) {
        const int unit = u0 + grp, cg = unit >> 2, h = unit & 3;
        gla_prep<true>(a, l, cg, h, lds, lds0 + GB_GW, tg);
        __syncthreads();
        { const int dvt = wg & 1, dir = wg >> 1;
            f32x16 acc;
#pragma unroll
            for (int i = 0; i < 16; ++i) acc[i] = 0.f;
            const unsigned char* ka = lds + (dir ? GB_KBT : GB_KFT) + r * GB_VROW + 16 * hh; const unsigned char* vb = lds + GB_VT + (32 * dvt + r) * GB_VROW; const int swv = (4 * dvt + (r >> 3)) & 7;
#pragma unroll
            for (int st = 0; st < 4; ++st) acc = __builtin_amdgcn_mfma_f32_32x32x16_bf16(*(const bf16x8*)(ka + 32 * st), *(const bf16x8*)(vb + (((2 * st + hh) ^ swv) << 4)), acc, 0, 0, 0);
            float* dst = DS + ((size_t)unit * 2 + dir) * 2048 + 32 * dvt + r;
#pragma unroll
            for (int i = 0; i < 16; ++i) { const int dk = (i & 3) + 8 * (i >> 2) + 4 * hh; dst[dk * 64] = acc[i] * ((const float*)(lds + GB_DEC))[dir * 32 + dk]; }
        }
        if (tg < 64) DEC[(size_t)unit * 64 + tg] = ((const float*)(lds + GB_DEC))[tg];
        __syncthreads();
    }
}
__device__ __forceinline__ void phase_gla_scan(const Args& a, int l) {
    const int tid = TID, bid = BID, gdim = GDIM;
    const float* DS = (const float*)(a.ws + WS_DS); const float* DEC = (const float*)(a.ws + WS_DEC); float* SST = (float*)(a.ws + WS_SST);
    for (int item = bid; item < 256; item += gdim) {
        if (tid < 128) {
            const int chain = item >> 4, e = (item & 15) * 128 + tid, dk = e >> 6;
            const int seq = 32 + (chain >> 3), h = (chain >> 1) & 3, dir = chain & 1, cg0 = 128 + (seq - 32) * 64;
            float S = a.in[dir ? I_SB : I_SF][(size_t)(((seq - 32) * NLAYER + l) * 4 + h) * 2048 + e];
#pragma unroll 1
            for (int i0 = 0; i0 < 64; i0 += 16) {
                float dc[16], ds[16];
#pragma unroll
                for (int j = 0; j < 16; ++j) { const int c = dir ? 63 - (i0 + j) : i0 + j; const size_t u2 = (size_t)((cg0 + c) * 4 + h) * 2 + dir; dc[j] = DEC[u2 * 32 + dk]; ds[j] = DS[u2 * 2048 + e]; }
#pragma unroll
                for (int j = 0; j < 16; ++j) { const int c = dir ? 63 - (i0 + j) : i0 + j; const size_t u2 = (size_t)((cg0 + c) * 4 + h) * 2 + dir; SST[u2 * 2048 + e] = S; S = dc[j] * S + ds[j]; }
            }
        }
    }
    for (int item = bid; item < 256 * 4; item += gdim) {
        const int chain = item >> 2, e = (item & 3) * 512 + tid, dk = e >> 6;
        const int seq = chain >> 3, h = (chain >> 1) & 3, dir = chain & 1, cg0 = seq * 4;
        float S = 0.f; float dc[4], ds[4]; size_t u2[4];
#pragma unroll
        for (int j = 0; j < 4; ++j) { const int c = dir ? 3 - j : j; u2[j] = (size_t)((cg0 + c) * 4 + h) * 2 + dir; dc[j] = DEC[u2[j] * 32 + dk]; ds[j] = DS[u2[j] * 2048 + e]; }
#pragma unroll
        for (int j = 0; j < 4; ++j) { SST[u2[j] * 2048 + e] = S; S = dc[j] * S + ds[j]; }
        a.out[(dir ? OUT_SB : OUT_SF) + (size_t)((seq * NLAYER + l) * 4 + h) * 2048 + e] = S;
    }
}
__device__ __forceinline__ void phase_gla_out(const Args& a, int l, unsigned char* lds0) {
    const int tid = TID, bid = BID, gdim = GDIM, lane = tid & 63, w = __builtin_amdgcn_readfirstlane(tid >> 6), r = lane & 31, hh = lane >> 5, grp = w >> 2, wg = w & 3, tg = tid & 255;
    unsigned char* lds = lds0 + grp * GB_GROUP;
    const bf16* P = (const bf16*)(a.ws + WS_P); const float* SST = (const float*)(a.ws + WS_SST); bf16* MIX = (bf16*)(a.ws + WS_MIX);
    gla_stage_gates(a, l, lds0, tid);
    for (int u0 = 2 * bid; u0 < 1024; u0 += 2 * gdim) {
        const int unit = u0 + grp, cg = unit >> 2, h = unit & 3;
        gla_prep<false>(a, l, cg, h, lds, lds0 + GB_GW, tg);
#pragma unroll
        for (int it = 0; it < 2; ++it) { const int rr = (tg >> 3) + 32 * it, c = (tg & 7) * 8, dir = rr >> 5, dk = rr & 31; const float* sp = SST + (size_t)unit * 4096 + rr * 64 + c;
          const f32x4 s0 = *(const f32x4*)sp, s1 = *(const f32x4*)(sp + 4);
          unsigned short* st = (unsigned short*)(lds + (dir ? GB_SBT : GB_SFT) + c * GB_QROW + ((((dk >> 3) ^ (tg & 3)) << 3) | (dk & 7)) * 2);
          st[0 * (GB_QROW / 2)] = (unsigned short)f2bf(s0.x); st[1 * (GB_QROW / 2)] = (unsigned short)f2bf(s0.y); st[2 * (GB_QROW / 2)] = (unsigned short)f2bf(s0.z); st[3 * (GB_QROW / 2)] = (unsigned short)f2bf(s0.w);
          st[4 * (GB_QROW / 2)] = (unsigned short)f2bf(s1.x); st[5 * (GB_QROW / 2)] = (unsigned short)f2bf(s1.y); st[6 * (GB_QROW / 2)] = (unsigned short)f2bf(s1.z); st[7 * (GB_QROW / 2)] = (unsigned short)f2bf(s1.w); }
        __syncthreads();
        const int tt = wg & 1, dvt = wg >> 1, tq = 32 * tt + r;
        f32x16 o;
#pragma unroll
        for (int i = 0; i < 16; ++i) o[i] = 0.f;
        {
            bf16x8 qF[2], qB[2];
#pragma unroll
            for (int st = 0; st < 2; ++st) { qF[st] = *(const bf16x8*)(lds + GB_QF + tq * GB_QROW + 32 * st + 16 * hh); qB[st] = *(const bf16x8*)(lds + GB_QB + tq * GB_QROW + 32 * st + 16 * hh); }
#pragma unroll
            for (int ts = 0; ts < 2; ++ts) {
                f32x16 af, ab;
#pragma unroll
                for (int i = 0; i < 16; ++i) { af[i] = 0.f; ab[i] = 0.f; }
#pragma unroll
                for (int st = 0; st < 2; ++st) {
                    af = __builtin_amdgcn_mfma_f32_32x32x16_bf16(*(const bf16x8*)(lds + GB_KF + (32 * ts + r) * GB_QROW + 32 * st + 16 * hh), qF[st], af, 0, 0, 0);
                    ab = __builtin_amdgcn_mfma_f32_32x32x16_bf16(*(const bf16x8*)(lds + GB_KB + (32 * ts + r) * GB_QROW + 32 * st + 16 * hh), qB[st], ab, 0, 0, 0); }
#pragma unroll
                for (int i = 0; i < 16; ++i) { const int sidx = 32 * ts + (i & 3) + 8 * (i >> 2) + 4 * hh; af[i] = (sidx <= tq ? af[i] : 0.f) + (sidx >= tq ? ab[i] : 0.f); }
#pragma unroll
                for (int s2 = 0; s2 < 2; ++s2) { const bf16x8 pf = at_pack_step(af, s2);
                    o = __builtin_amdgcn_mfma_f32_32x32x16_bf16(*(const bf16x8*)(lds + GB_VT + (32 * dvt + r) * GB_VROW + (((4 * ts + 2 * s2 + hh) ^ ((4 * dvt + (r >> 3)) & 7)) << 4)), pf, o, 0, 0, 0); }
            }
#pragma unroll
            for (int st = 0; st < 2; ++st) {
                const int qs = ((2 * st + hh) ^ ((r >> 3) & 3)) << 4;
                o = __builtin_amdgcn_mfma_f32_32x32x16_bf16(*(const bf16x8*)(lds + GB_SFT + (32 * dvt + r) * GB_QROW + qs), qF[st], o, 0, 0, 0);
                o = __builtin_amdgcn_mfma_f32_32x32x16_bf16(*(const bf16x8*)(lds + GB_SBT + (32 * dvt + r) * GB_QROW + qs), qB[st], o, 0, 0, 0); }
            float ss = 0.f;
#pragma unroll
            for (int i = 0; i < 16; ++i) ss += o[i] * o[i];
            ss += __shfl_xor(ss, 32);
            if (hh == 0) ((float*)(lds + GB_SSQ))[dvt * 64 + tq] = ss;
        }
        __syncthreads();
        {
            const float tot = ((const float*)(lds + GB_SSQ))[tq] + ((const float*)(lds + GB_SSQ))[64 + tq];
            const float rs = 1.0f / sqrtf(tot * (1.f / 64.f) + EPS);
            const int t = cg * 64 + tq, dv0 = 32 * dvt + 4 * hh;
            const float* gn = a.in[I_GNORM] + l * 256 + h * 64 + dv0; const bf16* gp = P + (size_t)t * INW + C_GG + h * 64 + dv0; bf16* op = MIX + (size_t)t * D + 256 + h * 64 + dv0;
#pragma unroll
            for (int g = 0; g < 4; ++g) { const u32x2 gw = *(const u32x2*)(gp + 8 * g); const f32x4 gnv = *(const f32x4*)(gn + 8 * g);
                const float y0 = o[4 * g] * rs * gnv.x * siluf(bflo(gw.x)), y1 = o[4 * g + 1] * rs * gnv.y * siluf(bfhi(gw.x)), y2 = o[4 * g + 2] * rs * gnv.z * siluf(bflo(gw.y)), y3 = o[4 * g + 3] * rs * gnv.w * siluf(bfhi(gw.y));
                *(u32x2*)(op + 8 * g) = (u32x2){pk2(y0, y1), pk2(y2, y3)}; }
        }
        __syncthreads();
    }
}

constexpr int AT_KROW = 144, AT_MAXK = 320, AT_VT = AT_MAXK * AT_KROW, AT_VROW = AT_MAXK * 2 + 16;
__device__ __forceinline__ void at_stage(unsigned char* lds, const float* kp, int kstride, const float* vp, int vstride, int nkeys, int tid) {
    f32x4 kk[4][2], vv[4][2];
#pragma unroll
    for (int it = 0; it < 4; ++it) { const int idx = min(tid + it * NT, nkeys * 8 - 1), key = idx >> 3, d8 = (idx & 7) * 8;
        kk[it][0] = *(const f32x4*)(kp + (size_t)key * kstride + d8); kk[it][1] = *(const f32x4*)(kp + (size_t)key * kstride + d8 + 4);
        vv[it][0] = *(const f32x4*)(vp + (size_t)key * vstride + d8); vv[it][1] = *(const f32x4*)(vp + (size_t)key * vstride + d8 + 4); }
#pragma unroll
    for (int it = 0; it < 4; ++it) { const int idx = tid + it * NT, key = idx >> 3, d8 = (idx & 7) * 8;
        if (idx < nkeys * 8) {
            const f32x4 k0 = kk[it][0], k1 = kk[it][1], v0 = vv[it][0], v1 = vv[it][1];
            *(u32x4*)(lds + key * AT_KROW + d8 * 2) = (u32x4){pk2(k0.x, k0.y), pk2(k0.z, k0.w), pk2(k1.x, k1.y), pk2(k1.z, k1.w)};
            const int pos0 = (key & ~31) + at_vpos(key & 31), pos = (((pos0 >> 3) ^ (idx & 7)) << 3) | (pos0 & 7);
            unsigned short* vt = (unsigned short*)(lds + AT_VT + d8 * AT_VROW + pos * 2);
            vt[0 * (AT_VROW / 2)] = (unsigned short)f2bf(v0.x); vt[1 * (AT_VROW / 2)] = (unsigned short)f2bf(v0.y); vt[2 * (AT_VROW / 2)] = (unsigned short)f2bf(v0.z); vt[3 * (AT_VROW / 2)] = (unsigned short)f2bf(v0.w);
            vt[4 * (AT_VROW / 2)] = (unsigned short)f2bf(v1.x); vt[5 * (AT_VROW / 2)] = (unsigned short)f2bf(v1.y); vt[6 * (AT_VROW / 2)] = (unsigned short)f2bf(v1.z); vt[7 * (AT_VROW / 2)] = (unsigned short)f2bf(v1.w); } }
}
__device__ __forceinline__ void at_stage16(unsigned char* lds, const bf16* kp, const bf16* vp, int stride, int nkeys, int tid) {
    u32x4 kk[5], vv[5];
#pragma unroll
    for (int it = 0; it < 5; ++it) { const int idx = min(tid + it * NT, nkeys * 8 - 1), key = idx >> 3, d8 = (idx & 7) * 8;
        kk[it] = *(const u32x4*)(kp + (size_t)key * stride + d8); vv[it] = *(const u32x4*)(vp + (size_t)key * stride + d8); }
#pragma unroll
    for (int it = 0; it < 5; ++it) { const int idx = tid + it * NT, key = idx >> 3, d8 = (idx & 7) * 8;
        if (idx < nkeys * 8) {
            *(u32x4*)(lds + key * AT_KROW + d8 * 2) = kk[it];
            const u32x4 v = vv[it];
            const int pos0 = (key & ~31) + at_vpos(key & 31), pos = (((pos0 >> 3) ^ (idx & 7)) << 3) | (pos0 & 7);
            unsigned short* vt = (unsigned short*)(lds + AT_VT + d8 * AT_VROW + pos * 2);
            vt[0 * (AT_VROW / 2)] = (unsigned short)v.x; vt[1 * (AT_VROW / 2)] = (unsigned short)(v.x >> 16); vt[2 * (AT_VROW / 2)] = (unsigned short)v.y; vt[3 * (AT_VROW / 2)] = (unsigned short)(v.y >> 16);
            vt[4 * (AT_VROW / 2)] = (unsigned short)v.z; vt[5 * (AT_VROW / 2)] = (unsigned short)(v.z >> 16); vt[6 * (AT_VROW / 2)] = (unsigned short)v.w; vt[7 * (AT_VROW / 2)] = (unsigned short)(v.w >> 16); } }
}
__device__ __forceinline__ float xhalf_max(float x) { const auto r = __builtin_amdgcn_permlane32_swap(__builtin_bit_cast(unsigned, x), __builtin_bit_cast(unsigned, x), false, false);
    return fmaxf(__builtin_bit_cast(float, r[0]), __builtin_bit_cast(float, r[1])); }
__device__ __forceinline__ float xhalf_sum(float x) { const auto r = __builtin_amdgcn_permlane32_swap(__builtin_bit_cast(unsigned, x), __builtin_bit_cast(unsigned, x), false, false);
    return __builtin_bit_cast(float, r[0]) + __builtin_bit_cast(float, r[1]); }
__device__ __forceinline__ f32x16 at_scores(const unsigned char* lds, int tile, const bf16x8 (&qf)[4], int r, int h) {
    f32x16 sacc;
#pragma unroll
    for (int i = 0; i < 16; ++i) sacc[i] = 0.f;
    const unsigned char* kr = lds + (tile * 32 + r) * AT_KROW + 16 * h;
#pragma unroll
    for (int st = 0; st < 4; ++st) { const bf16x8 kf = *(const bf16x8*)(kr + 32 * st); sacc = __builtin_amdgcn_mfma_f32_32x32x16_bf16(kf, qf[st], sacc, 0, 0, 0); }
    return sacc;
}
template <bool MASKED>
__device__ __forceinline__ void at_tiles(const unsigned char* lds, int ntiles, const bf16x8 (&qf)[4], f32x16& o0, f32x16& o1, float& m, float& lsum, int r, int h, int qpos, int kpos0, int qlo, int qhi) {
    f32x16 snext = at_scores(lds, 0, qf, r, h);
    for (int tile = 0; tile < ntiles; ++tile) {
        f32x16 sacc = snext;
        if (tile + 1 < ntiles) snext = at_scores(lds, tile + 1, qf, r, h);
        if (MASKED) { const int k0 = kpos0 + tile * 32;
            if (k0 < qhi - 128 || k0 + 31 > qlo + 128) {
#pragma unroll
                for (int i = 0; i < 16; ++i) { const int dlt = qpos - (k0 + (i & 3) + 8 * (i >> 2) + 4 * h); if ((unsigned)(dlt + 128) > 256u) sacc[i] = -1.0e30f; } } }
        float mt = sacc[0];
#pragma unroll
        for (int i = 1; i < 16; ++i) mt = fmaxf(mt, sacc[i]);
        mt = fmaxf(mt, __shfl_xor(mt, 32));
        const float mn = fmaxf(m, mt), alpha = __builtin_amdgcn_exp2f(m - mn);
        float rs = 0.f;
#pragma unroll
        for (int i = 0; i < 16; ++i) { sacc[i] = __builtin_amdgcn_exp2f(sacc[i] - mn); rs += sacc[i]; }
        rs += __shfl_xor(rs, 32);
        lsum = lsum * alpha + rs; m = mn;
#pragma unroll
        for (int i = 0; i < 16; ++i) { o0[i] *= alpha; o1[i] *= alpha; }
        const unsigned char* vr = lds + AT_VT + r * AT_VROW; const int sw0 = (r >> 3) & 7, sw1 = (4 + (r >> 3)) & 7;
#pragma unroll
        for (int s2 = 0; s2 < 2; ++s2) { const bf16x8 pf = at_pack_step(sacc, s2); const int q = tile * 4 + 2 * s2 + h;
            const bf16x8 v0 = *(const bf16x8*)(vr + ((q ^ sw0) << 4)), v1 = *(const bf16x8*)(vr + 32 * AT_VROW + ((q ^ sw1) << 4));
            o0 = __builtin_amdgcn_mfma_f32_32x32x16_bf16(v0, pf, o0, 0, 0, 0); o1 = __builtin_amdgcn_mfma_f32_32x32x16_bf16(v1, pf, o1, 0, 0, 0); }
    }
}
__device__ __forceinline__ void phase_attn(const Args& a, int l, unsigned char* lds) {
    const int tid = TID, bid = BID, gdim = GDIM, lane = tid & 63, w = tid >> 6, r = lane & 31, h = lane >> 5;
    const bf16* P = (const bf16*)(a.ws + WS_P); bf16* MIX = (bf16*)(a.ws + WS_MIX);
    constexpr float LOG2E = 1.4426950408889634f;
    for (int unit = bid; unit < 512; unit += gdim) {
        const int tb = unit >> 1, kv = unit & 1, t0 = tb * 64, hq = kv * 4 + (w >> 1), tq = t0 + 32 * (w & 1) + r;
        const bool lat = t0 >= NCTX;
        bf16x8 qf[4];
        { const bf16* qp = P + (size_t)tq * INW + C_AQ + hq * 64 + 8 * h;
#pragma unroll
          for (int st = 0; st < 4; ++st) qf[st] = *(const bf16x8*)(qp + 16 * st); }
        const int tl = (tq - NCTX) & 4095;
        f32x16 o0, o1;
#pragma unroll
        for (int i = 0; i < 16; ++i) { o0[i] = 0.f; o1[i] = 0.f; }
        float m = a.in[I_SINK][l * 8 + hq] * LOG2E, lsum = 1.f;
        if (!lat) {
            const int s0 = t0 & ~255;
            at_stage16(lds, P + (size_t)s0 * INW + C_AK + kv * 64, P + (size_t)s0 * INW + C_AV + kv * 64, INW, 256, tid);
            __syncthreads();
            at_tiles<false>(lds, 8, qf, o0, o1, m, lsum, r, h, 0, 0, 0, 0);
            __syncthreads();
        } else {
            const int b = (t0 - NCTX) >> 12, tl0 = (t0 - NCTX) & 4095, lo = max(tl0 - 128, 0), hi = min(tl0 + 64 + 128, 4096);
            at_stage16(lds, P + (size_t)(NCTX + b * 4096 + lo) * INW + C_AK + kv * 64, P + (size_t)(NCTX + b * 4096 + lo) * INW + C_AV + kv * 64, INW, hi - lo, tid);
            __syncthreads();
            at_tiles<true>(lds, (hi - lo) >> 5, qf, o0, o1, m, lsum, r, h, tl, lo, tl0 + 32 * (w & 1), tl0 + 32 * (w & 1) + 31);
            __syncthreads();
            const size_t cb = (size_t)(b * NLAYER + l) * 256 * 128 + kv * 64;
            at_stage(lds, a.in[I_CK] + cb, 128, a.in[I_CV] + cb, 128, 256, tid);
            __syncthreads();
            at_tiles<false>(lds, 8, qf, o0, o1, m, lsum, r, h, 0, 0, 0, 0);
            __syncthreads();
        }
        const float inv = 1.f / lsum;
        bf16* op = MIX + (size_t)tq * D + 512 + hq * 64 + 4 * h;
#pragma unroll
        for (int g = 0; g < 4; ++g) {
            *(u32x2*)(op + 8 * g) = (u32x2){pk2(o0[4 * g] * inv, o0[4 * g + 1] * inv), pk2(o0[4 * g + 2] * inv, o0[4 * g + 3] * inv)};
            *(u32x2*)(op + 32 + 8 * g) = (u32x2){pk2(o1[4 * g] * inv, o1[4 * g + 1] * inv), pk2(o1[4 * g + 2] * inv, o1[4 * g + 3] * inv)}; }
    }
}

template <int N> __device__ __forceinline__ void bitonic_sort_desc(float (&v)[N]) {
#pragma unroll
    for (int k = 2; k <= N; k <<= 1)
#pragma unroll
        for (int j = k >> 1; j > 0; j >>= 1)
#pragma unroll
            for (int i = 0; i < N; ++i) { const int p = i ^ j; if (p > i) { const bool up = ((i & k) == 0) || (k == N);
                const float a = v[i], b = v[p], hi = __builtin_fmaxf(a, b), lo = __builtin_fminf(a, b); v[i] = up ? hi : lo; v[p] = up ? lo : hi; } }
}
__device__ __forceinline__ void merge_top16(float (&a)[16], const float (&b)[16]) {
#pragma unroll
    for (int i = 0; i < 16; ++i) a[i] = __builtin_fmaxf(a[i], b[15 - i]);
#pragma unroll
    for (int j = 8; j > 0; j >>= 1)
#pragma unroll
        for (int i = 0; i < 16; ++i) { const int p = i ^ j; if (p > i) { const float x = a[i], y = a[p]; a[i] = __builtin_fmaxf(x, y); a[p] = __builtin_fminf(x, y); } }
}
__device__ __forceinline__ void topk_list(const bf16* sk  , const bf16* qp, int hh, float (&top)[16]) {
    bf16x8 qf[4];
#pragma unroll
    for (int st = 0; st < 4; ++st) qf[st] = *(const bf16x8*)(qp + 16 * st);
#pragma unroll
    for (int kt = 0; kt < 4; ++kt) {
        bf16x8 skf[4];
#pragma unroll
        for (int st = 0; st < 4; ++st) skf[st] = *(const bf16x8*)(sk + (size_t)(32 * kt) * 64 + 16 * st);
        f32x16 acc;
#pragma unroll
        for (int i = 0; i < 16; ++i) acc[i] = 0.f;
#pragma unroll
        for (int st = 0; st < 4; ++st) acc = __builtin_amdgcn_mfma_f32_32x32x16_bf16(skf[st], qf[st], acc, 0, 0, 0);
        float v[16];
#pragma unroll
        for (int i = 0; i < 16; ++i) v[i] = __uint_as_float((__float_as_uint(acc[i]) & ~127u) | (unsigned)(32 * kt + (i & 3) + 8 * (i >> 2)) | (unsigned)(4 * hh));
        bitonic_sort_desc<16>(v);
        if (kt == 0) {
#pragma unroll
            for (int i = 0; i < 16; ++i) top[i] = v[i];
        } else merge_top16(top, v);
    }
    float oth[16];
#pragma unroll
    for (int i = 0; i < 16; ++i) oth[i] = __shfl_xor(top[i], 32);
    merge_top16(top, oth);
}
__device__ __forceinline__ void topk_pass(const Args& a, int l, float* lds, int pass) {
    const int tid = TID, lane = tid & 63, w = __builtin_amdgcn_readfirstlane(tid >> 6), r = lane & 31, hh = lane >> 5;
    const bf16* Qb = (const bf16*)(a.ws + WS_Q); int* EXP = (int*)(a.ws + WS_EXP); float* GATE = (float*)(a.ws + WS_GATE);
    {
        const int h = w, tbase = pass * 64;
#pragma unroll 1
        for (int tt = 0; tt < 2; ++tt) {
            float top[1][2][16];
#pragma unroll
            for (int p = 0; p < 2; ++p) {
                topk_list((const bf16*)(a.ws + WS_SKB) + (size_t)(l * 16 + 2 * h + p) * 128 * 64 + (size_t)r * 64 + 8 * hh, Qb + ((size_t)(2 * h + p) * NTOK + tbase + 32 * tt + r) * 64 + 8 * hh, hh, top[0][p]);
            }
            const int lane2 = lv(tid) & 63, r2 = lane2 & 31;
            const int t = tbase + 32 * tt + r2;
            float* tab = lds + w * 1024 + r2 * 32;
            if (hh == 0) {
#pragma unroll
                for (int i = 0; i < 16; i += 4) { *(f32x4*)(tab + i) = (f32x4){top[0][0][i], top[0][0][i + 1], top[0][0][i + 2], top[0][0][i + 3]};
                                                   *(f32x4*)(tab + 16 + i) = (f32x4){top[0][1][i], top[0][1][i + 1], top[0][1][i + 2], top[0][1][i + 3]}; } }
            float va[16], vb[16];
#pragma unroll
            for (int i = 0; i < 16; ++i) { va[i] = __uint_as_float(__float_as_uint(top[0][0][i]) & ~127u); vb[i] = __uint_as_float(__float_as_uint(top[0][1][i]) & ~127u); }
            float t2[16];
#pragma unroll
            for (int i = 0; i < 16; ++i) t2[i] = -3.0e38f;
#pragma unroll
            for (int i = 0; i < 16; ++i)
#pragma unroll
                for (int j = 0; j < 16 / (i + 1); ++j) {
                    float x = __uint_as_float((__float_as_uint(va[i] + vb[j]) & ~255u) | (unsigned)(i * 16 + j));
#pragma unroll
                    for (int k = 0; k < 16; ++k) { const float hi = __builtin_fmaxf(t2[k], x); x = __builtin_fminf(t2[k], x); t2[k] = hi; }
                }
            float e[16], sum = 0.f; const float m = __uint_as_float(__float_as_uint(t2[0]) & ~255u);
#pragma unroll
            for (int k = 0; k < 16; ++k) { e[k] = expf(__uint_as_float(__float_as_uint(t2[k]) & ~255u) - m); sum += e[k]; }
            const float inv = 1.f / sum;
            asm volatile("s_waitcnt lgkmcnt(0)" ::: "memory");
            if (hh == 0) {
#pragma unroll
                for (int k = 0; k < 16; k += 4) { int ex[4]; float gv[4];
#pragma unroll
                    for (int q = 0; q < 4; ++q) { const unsigned pos = __float_as_uint(t2[k + q]) & 255u;
                        const unsigned ei = __float_as_uint(tab[pos >> 4]) & 127u, ej = __float_as_uint(tab[16 + (pos & 15u)]) & 127u; ex[q] = (int)(ei * 128u + ej); gv[q] = e[k + q] * inv; }
                    *(int4*)(EXP + (size_t)t * 128 + h * 16 + k) = make_int4(ex[0], ex[1], ex[2], ex[3]);
                    *(f32x4*)(GATE + (size_t)t * 128 + h * 16 + k) = (f32x4){gv[0], gv[1], gv[2], gv[3]}; } }
            asm volatile("s_waitcnt lgkmcnt(0)" ::: "memory");
        }
    }
}
typedef float f32x2 __attribute__((ext_vector_type(2)));
typedef long i64_t;
constexpr int NTK = 8, PS_TOK = 1536, PS_WAVE = NTK * PS_TOK + 2048 + 64;
static_assert(PS_WAVE * NWAVES <= 131072, "PEER scratch");
__device__ __forceinline__ i64_t lo64(u32x4 v) { return (i64_t)(((unsigned long long)v.y << 32) | (unsigned long long)v.x); }
__device__ __forceinline__ i64_t hi64(u32x4 v) { return (i64_t)(((unsigned long long)v.w << 32) | (unsigned long long)v.z); }
#define MFMA8(A_, B_, C_) __builtin_amdgcn_mfma_f32_16x16x32_fp8_fp8((A_), (B_), (C_), 0, 0, 0)
__device__ __forceinline__ void phase_peer(const Args& a, int l, unsigned char* lds) {
    const int tid = TID, bid = BID, gdim = GDIM, lane = tid & 63, w = __builtin_amdgcn_readfirstlane(tid >> 6);
    bf16* H = (bf16*)(a.ws + WS_H); float* X = (float*)(a.ws + WS_X);
    const int* EXP = (const int*)(a.ws + WS_EXP); const float* GATE = (const float*)(a.ws + WS_GATE);
    const float* MOD = (const float*)(a.ws + WS_MOD);
    const unsigned char* U8 = a.ws + WS_U8 + (size_t)l * 16384 * D; const unsigned char* V8 = a.ws + WS_V8 + (size_t)l * 16384 * D;
    const float* SUV = (const float*)(a.ws + WS_SUV) + (size_t)l * 16384 * 2;
    unsigned char* wl = lds + w * PS_WAVE;
    const int n16 = lane & 15, rg = lane >> 4;
    int npass = 0;
    for (int pass = bid; pass < NTOK / (NWAVES * NTK); pass += gdim, ++npass) {
        const int tb = pass * (NWAVES * NTK) + NTK * w;
        const int dirn = npass & 1;
        __syncthreads(); topk_pass(a, l, (float*)lds, pass); __syncthreads();
        {
            i64_t hq[NTK][2]; float invs[NTK];
            const unsigned lane16 = 16u * (unsigned)lane; const bool odd0 = (lane & 1) != 0, odd1 = (lane & 2) != 0;
            const bool dsel1 = (n16 & 1) != 0, dsel2 = (n16 & 2) != 0, ddiag = rg == (n16 >> 2);
            unsigned char* const dummy_ = wl + NTK * PS_TOK + 4 * lane;
            { const int lane = lv(tid) & 63;
#pragma unroll
            for (int j = 0; j < NTK; ++j) {
                const int t = tb + j;
                { const u32x4 h0 = *(const u32x4*)(H + (size_t)t * D + 16 * lane), h1 = *(const u32x4*)(H + (size_t)t * D + 16 * lane + 8);
                  float hf[16];
#pragma unroll
                  for (int q = 0; q < 4; ++q) { hf[2 * q] = bflo(h0[q]); hf[2 * q + 1] = bfhi(h0[q]); hf[8 + 2 * q] = bflo(h1[q]); hf[8 + 2 * q + 1] = bfhi(h1[q]); }
                  float m = 0.f;
#pragma unroll
                  for (int q = 0; q < 16; ++q) m = fmaxf(m, fabsf(hf[q]));
                  m = fmaxf(wave_max_u(m), 1e-20f);
                  const float S = 240.f / m; invs[j] = m * (1.f / 240.f);
                  unsigned ph[4];
#pragma unroll
                  for (int q = 0; q < 4; ++q) { int pk = __builtin_amdgcn_cvt_pk_fp8_f32(hf[4 * q] * S, hf[4 * q + 1] * S, 0, false); pk = __builtin_amdgcn_cvt_pk_fp8_f32(hf[4 * q + 2] * S, hf[4 * q + 3] * S, pk, true); ph[q] = (unsigned)pk; }
                  hq[j][0] = lo64((u32x4){ph[0], ph[1], ph[2], ph[3]}); hq[j][1] = hi64((u32x4){ph[0], ph[1], ph[2], ph[3]}); }
                const int e0 = EXP[(size_t)t * 128 + lane], e1 = EXP[(size_t)t * 128 + 64 + lane];
                const float g0 = GATE[(size_t)t * 128 + lane], g1 = GATE[(size_t)t * 128 + 64 + lane];
                unsigned* SL = (unsigned*)(wl + j * PS_TOK); float* SG = (float*)(wl + j * PS_TOK + 512); float* SU = (float*)(wl + j * PS_TOK + 1024);
                volatile unsigned* CNT = (volatile unsigned*)(wl + NTK * PS_TOK);
#pragma unroll
                for (int q = 0; q < 8; ++q) CNT[lane + 64 * q] = 0u;
                const unsigned r0 = __hip_atomic_fetch_add((unsigned*)&CNT[e0 >> 5], 1u, __ATOMIC_RELAXED, __HIP_MEMORY_SCOPE_WORKGROUP);
                const unsigned r1 = __hip_atomic_fetch_add((unsigned*)&CNT[e1 >> 5], 1u, __ATOMIC_RELAXED, __HIP_MEMORY_SCOPE_WORKGROUP);
                asm volatile("s_waitcnt lgkmcnt(0)" ::: "memory");
                { unsigned c[8], run = 0u;
#pragma unroll
                  for (int q = 0; q < 8; ++q) { c[q] = CNT[8 * lane + q]; run += c[q]; }
                  const float incl = wave_prefix_incl((float)run, lane); unsigned bb = (unsigned)incl - run;
#pragma unroll
                  for (int q = 0; q < 8; ++q) { CNT[8 * lane + q] = bb; bb += c[q]; } }
                asm volatile("s_waitcnt lgkmcnt(0)" ::: "memory");
                const int pos0 = (int)(CNT[e0 >> 5] + r0), pos1 = (int)(CNT[e1 >> 5] + r1);
                asm volatile("s_waitcnt lgkmcnt(0)" ::: "memory");
                { const f32x2 sc0 = *(const f32x2*)(SUV + (size_t)e0 * 2), sc1 = *(const f32x2*)(SUV + (size_t)e1 * 2);
                  SL[pos0] = (unsigned)e0; SG[pos0] = g0 * sc0.y; SU[pos0] = sc0.x; SL[pos1] = (unsigned)e1; SG[pos1] = g1 * sc1.y; SU[pos1] = sc1.x; }
            }
            }
            asm volatile("s_waitcnt lgkmcnt(0)" ::: "memory");
#define PU_IDS(R, jj, bb) do { R##n = *(const u32x4*)(wl + (jj) * PS_TOK + 16 * (bb)); } while (0)
#define PU_LOAD(R, jj, bb) do { R##b = (bb); \
                R##s = *(const float*)(wl + (jj) * PS_TOK + 1024 + 16 * (bb) + 4 * (lane & 3)); \
                _Pragma("unroll") for (int i = 0; i < 4; ++i) { const unsigned e_ = (unsigned)__builtin_amdgcn_readfirstlane((int)R##n[i]); R##u[i] = *(const u32x4*)(U8 + (size_t)e_ * D + lane16); } } while (0)
#define PU_COMP(R, jj) do { float dd_[4]; \
                _Pragma("unroll") for (int i = 0; i < 4; ++i) { f32x4 d_ = {0.f, 0.f, 0.f, 0.f}; const i64_t al_ = lo64(R##u[i]), ah_ = hi64(R##u[i]); \
                    d_ = MFMA8(al_, hq[jj][0], d_); d_ = MFMA8(ah_, hq[jj][1], d_); \
                    const float s01_ = dsel1 ? d_[1] : d_[0], s23_ = dsel1 ? d_[3] : d_[2]; const float s_ = dsel2 ? s23_ : s01_; dd_[i] = ddiag ? s_ : 0.f; } \
                const float a01_ = odd0 ? dd_[1] : dd_[0], b01_ = odd0 ? dd_[0] : dd_[1], a23_ = odd0 ? dd_[3] : dd_[2], b23_ = odd0 ? dd_[2] : dd_[3]; \
                const float x01_ = a01_ + dpp_mov<0xB1>(b01_), x23_ = a23_ + dpp_mov<0xB1>(b23_); \
                float x_ = (odd1 ? x23_ : x01_) + dpp_mov<0x4E>(odd1 ? x01_ : x23_); \
                x_ += dpp_mov<0x124>(x_); x_ += dpp_mov<0x128>(x_); \
                const f32x4 t4_ = __builtin_amdgcn_mfma_f32_16x16x4f32(x_, 1.0f, (f32x4){0.f, 0.f, 0.f, 0.f}, 0, 0, 0); \
                const float xt_ = odd1 ? (odd0 ? t4_[3] : t4_[2]) : (odd0 ? t4_[1] : t4_[0]); \
                *(float*)(lane < 4 ? wl + (jj) * PS_TOK + 1024 + 16 * R##b + 4 * lane : dummy_) = xt_ * (R##s * invs[jj]); } while (0)
            {
                u32x4 R0u[4], R1u[4], R2u[4], R3u[4], R0n, R1n, R2n, R3n; int R0b, R1b, R2b, R3b; float R0s, R1s, R2s, R3s;
                { const int b0 = dirn ? 31 : 0;
                  PU_IDS(R0, 0, b0); PU_IDS(R1, 1, b0); PU_IDS(R2, 2, b0); PU_IDS(R3, 3, b0);
                  PU_LOAD(R0, 0, b0); PU_LOAD(R1, 1, b0); PU_LOAD(R2, 2, b0); PU_LOAD(R3, 3, b0);
                  PU_IDS(R0, 4, b0); PU_IDS(R1, 5, b0); PU_IDS(R2, 6, b0); PU_IDS(R3, 7, b0); }
#pragma unroll 1
                for (int bi = 0; bi < 32; ++bi) {
                    const int b = dirn ? 31 - bi : bi, bn = dirn ? max(b - 1, 0) : min(b + 1, 31);
                    __builtin_amdgcn_s_barrier();
                    PU_COMP(R0, 0); PU_LOAD(R0, 4, b); PU_IDS(R0, 0, bn);
                    PU_COMP(R1, 1); PU_LOAD(R1, 5, b); PU_IDS(R1, 1, bn);
                    PU_COMP(R2, 2); PU_LOAD(R2, 6, b); PU_IDS(R2, 2, bn);
                    PU_COMP(R3, 3); PU_LOAD(R3, 7, b); PU_IDS(R3, 3, bn);
                    PU_COMP(R0, 4); PU_LOAD(R0, 0, bn); PU_IDS(R0, 4, bn);
                    PU_COMP(R1, 5); PU_LOAD(R1, 1, bn); PU_IDS(R1, 5, bn);
                    PU_COMP(R2, 6); PU_LOAD(R2, 2, bn); PU_IDS(R2, 6, bn);
                    PU_COMP(R3, 7); PU_LOAD(R3, 3, bn); PU_IDS(R3, 7, bn);
                }
            }
#undef PU_IDS
#undef PU_LOAD
#undef PU_COMP
            asm volatile("s_waitcnt lgkmcnt(0)" ::: "memory");
#pragma unroll
            for (int j = 0; j < NTK; ++j) {
                unsigned* sc = (unsigned*)(wl + j * PS_TOK + 512);
                float cc_[2];
#pragma unroll
                for (int q = 0; q < 2; ++q) {
                    const float gq_ = __builtin_bit_cast(float, sc[lane + 64 * q]), dv_ = __builtin_bit_cast(float, sc[128 + lane + 64 * q]);
                    const float av_ = fabsf(dv_), tt_ = __builtin_amdgcn_rcpf(av_ * 0.2316418882f + 1.0f);
                    float qq_ = tt_ * 0.5307027145f + (-0.7265760135f); qq_ = qq_ * tt_ + 0.7107068705f; qq_ = qq_ * tt_ + (-0.142248368f); qq_ = qq_ * tt_ + 0.127414796f; qq_ = qq_ * tt_;
                    const float mm_ = dv_ * (qq_ * __builtin_amdgcn_exp2f((dv_ * dv_) * (-0.72134752044f))); cc_[q] = gq_ * (dv_ < 0.f ? mm_ : dv_ - mm_); }
                const float c0 = cc_[0], c1 = cc_[1];
                const float m = fmaxf(wave_max_u(fmaxf(fabsf(c0), fabsf(c1))), 1e-30f);
                const float S = 240.f / m; if (lane == 0) *(float*)(wl + NTK * PS_TOK + 2048 + 4 * j) = m * (1.f / 240.f);
                const float s0 = c0 * S, s1 = c1 * S;
                const int pk = __builtin_amdgcn_cvt_pk_fp8_f32(s0, s1, 0, false); const f32x2 b = __builtin_amdgcn_cvt_pk_f32_fp8(pk, false);
                const int pq = __builtin_amdgcn_cvt_pk_fp8_f32(s0 - b.x, s1 - b.y, 0, false);
                const unsigned* sl = (const unsigned*)(wl + j * PS_TOK);
                sc[lane] = sl[lane] | (((unsigned)pk & 0xffu) << 16) | (((unsigned)pq & 0xffu) << 24); sc[64 + lane] = sl[64 + lane] | (((unsigned)pk & 0xff00u) << 8) | (((unsigned)pq & 0xff00u) << 16);
            }
        }
        asm volatile("s_waitcnt lgkmcnt(0)" ::: "memory");
        {
            const int sh8 = n16 < 8 ? 16 : 24, shp = 8 * (n16 & 7);
#define PV_IDS(R, jj, qq) do { const int q_ = min((qq), 31); const int b_ = vd ? q_ : 31 - q_; R##w = *(const unsigned*)(wl + (jj) * PS_TOK + 512 + 16 * b_ + 4 * rg); } while (0)
#define PV_LOAD(R) do { R##v = *(const u32x4*)(V8 + (size_t)(R##w & 0xffffu) * D + 16 * n16 + 256 * hp); R##g = R##w; } while (0)
#define PV_COMP(R, jj) do { const i64_t a_ = (i64_t)((unsigned long long)((R##g >> sh8) & 0xffu) << shp); \
                av[jj][0] = MFMA8(a_, lo64(R##v), av[jj][0]); av[jj][1] = MFMA8(a_, hi64(R##v), av[jj][1]); } while (0)
#define PV_STEP(R, jj, qq) do { PV_COMP(R, jj); PV_LOAD(R); PV_IDS(R, jj, qq); __builtin_amdgcn_sched_barrier(0); } while (0)
#define PV_ALL(X_, qq) do { X_(A, 0, qq); X_(B, 1, qq); X_(C, 2, qq); X_(E, 3, qq); X_(F, 4, qq); X_(G, 5, qq); X_(I, 6, qq); X_(J, 7, qq); } while (0)
#define PV_IDS0(R, jj, qq) PV_IDS(R##0, jj, qq)
#define PV_IDS1(R, jj, qq) PV_IDS(R##1, jj, qq)
#define PV_LOAD0(R, jj, qq) PV_LOAD(R##0)
#define PV_LOAD1(R, jj, qq) PV_LOAD(R##1)
#define PV_STEP0(R, jj, qq) PV_STEP(R##0, jj, qq)
#define PV_STEP1(R, jj, qq) PV_STEP(R##1, jj, qq)
#pragma unroll 1
            for (int hp = 0; hp < 4; ++hp) {
                const int vd = (dirn ^ hp) & 1;
                f32x4 av[NTK][2];
#pragma unroll
                for (int j = 0; j < NTK; ++j) { av[j][0] = (f32x4){0.f, 0.f, 0.f, 0.f}; av[j][1] = (f32x4){0.f, 0.f, 0.f, 0.f}; }
                {
                    u32x4 A0v, A1v, B0v, B1v, C0v, C1v, E0v, E1v, F0v, F1v, G0v, G1v, I0v, I1v, J0v, J1v;
                    unsigned A0w, A1w, B0w, B1w, C0w, C1w, E0w, E1w, F0w, F1w, G0w, G1w, I0w, I1w, J0w, J1w, A0g, A1g, B0g, B1g, C0g, C1g, E0g, E1g, F0g, F1g, G0g, G1g, I0g, I1g, J0g, J1g;
                    PV_ALL(PV_IDS0, 0); PV_ALL(PV_IDS1, 1);
                    PV_ALL(PV_LOAD0, 0); PV_ALL(PV_LOAD1, 0);
                    PV_ALL(PV_IDS0, 2); PV_ALL(PV_IDS1, 3);
#pragma unroll 1
                    for (int q = 0; q < 32; q += 2) { __builtin_amdgcn_s_barrier(); PV_ALL(PV_STEP0, q + 4); PV_ALL(PV_STEP1, q + 5); }
                }
                const int lq = lv(lane), pe = lq >> 5, col0 = 16 * (lq & 15) + 8 * (lq >> 5) + 4 * ((lq >> 4) & 1);
#pragma unroll
                for (int j = 0; j < NTK; ++j) {
                    const int t = tb + j, grp = grp_of(t);
                    const float* gt = MOD + (size_t)(l * 3 + grp) * 6144 + 5 * D + col0 + 256 * hp; float* xr = X + (size_t)t * D + col0 + 256 * hp;
                    const f32x4 mine = pe ? av[j][1] : av[j][0], send = pe ? av[j][0] : av[j][1];
                    f32x4 yv;
                    const float isc = *(const float*)(wl + NTK * PS_TOK + 2048 + 4 * j);
#pragma unroll
                    for (int q = 0; q < 4; ++q) yv[q] = (mine[q] + __shfl_xor(send[q], 32)) * isc;
                    const f32x4 xv = *(const f32x4*)xr, gv = *(const f32x4*)gt;
                    *(f32x4*)xr = xv + gv * yv;
                }
            }
#undef PV_IDS
#undef PV_LOAD
#undef PV_COMP
#undef PV_STEP
#undef PV_ALL
#undef PV_IDS0
#undef PV_IDS1
#undef PV_LOAD0
#undef PV_LOAD1
#undef PV_STEP0
#undef PV_STEP1
            asm volatile("s_waitcnt vmcnt(0)" ::: "memory");
            const int lq = lv(lane), col0 = 16 * (lq & 15) + 8 * (lq >> 5) + 4 * ((lq >> 4) & 1);
#pragma unroll
            for (int j = 0; j < NTK; ++j) {
                const int t = tb + j, grp = grp_of(t);
                const float* xr = X + (size_t)t * D + col0;
                f32x4 x2[4];
                float ssq = 0.f;
#pragma unroll
                for (int c = 0; c < 4; ++c) { x2[c] = *(const f32x4*)(xr + 256 * c); ssq += x2[c].x * x2[c].x + x2[c].y * x2[c].y + x2[c].z * x2[c].z + x2[c].w * x2[c].w; }
                const float ss = wave_sum(ssq);
                const float rr = 1.0f / sqrtf(ss * (1.f / D) + EPS);
                if (l < NLAYER - 1) {
                    const float* m = MOD + (size_t)((l + 1) * 3 + grp) * 6144 + col0; const float* gain = a.in[I_N1] + (l + 1) * D + col0;
#pragma unroll
                    for (int c = 0; c < 4; ++c) {
                        const f32x4 gn = *(const f32x4*)(gain + 256 * c), msc = *(const f32x4*)(m + D + 256 * c), msh = *(const f32x4*)(m + 256 * c);
                        const f32x4 o = x2[c] * rr * gn * (1.f + msc) + msh;
                        *(u32x2*)(H + (size_t)t * D + col0 + 256 * c) = (u32x2){pk2(o.x, o.y), pk2(o.z, o.w)}; }
                } else {
                    const float* gain = a.in[I_FNORM] + col0; float* op = a.out + (size_t)t * D + col0;
#pragma unroll
                    for (int c = 0; c < 4; ++c) *(f32x4*)(op + 256 * c) = x2[c] * rr * *(const f32x4*)(gain + 256 * c);
                }
            }
        }
    }
}

__global__ void __launch_bounds__(NT, 2) mega_fwd(KArgs ka) {
    extern __shared__ __attribute__((aligned(16))) unsigned char lds[];
    float* ldsf = (float*)lds;
    volatile LAS unsigned* MISC = (volatile LAS unsigned*)((LAS unsigned char*)lds + 131072 + 320);
    if (threadIdx.x < 32) MISC[threadIdx.x] = 0u;
    volatile LAS unsigned* TBL = (volatile LAS unsigned*)((LAS unsigned char*)lds + 131072 + 512);
    if (threadIdx.x == 0) {
#pragma unroll
        for (int i = 0; i < 27; ++i) { const unsigned long long p = (unsigned long long)((const unsigned char*)ka.in[i] - ka.ws); TBL[2 * i] = (unsigned)p; TBL[2 * i + 1] = (unsigned)(p >> 32); }
    }
    Args a; a.in.t = TBL; a.in.ws = ka.ws; a.out = ka.out; a.ws = ka.ws;
    __syncthreads();
    XcdBarrier bar = xcd_barrier_post((unsigned*)(a.ws + WS_CTL) + CW_BAR, MISC + 8);
#define GRID_BAR() xcd_barrier(bar)
        PG8_LAS unsigned char* glds = (PG8_LAS unsigned char*)lds;
#define FA fresh(a)
#define WSP(T, off) ((T*)(fresh(a).ws + (off)))
#define MODL (WSP(const float, WS_MOD) + (size_t)l * 3 * 6144)
    constexpr int NPH = 8, NSTEP = 2 + NLAYER * NPH;
    for (int step = 0; step < NSTEP; ++step) {
        if (step == 0) phase_prologue(fresh(a), (float*)fresh_lds(lds));
        else if (step == 1) { const int l = 0; phase_norm(a.in[I_XP], a.in[I_XS], a.in[I_N1], MODL, 0, D, WSP(bf16, WS_H)); }
        else {
            const int l = (step - 2) / NPH, ph = (step - 2) % NPH;
            switch (ph) {
            case 0: { pg8::Gemm g{WSP(const bf16, WS_H), WSP(const bf16, WS_WIN_T) + (size_t)l * 2048 * D, NTOK, 2048, D}; pg8::StaticOrder S; S.init(NTOK, 2048, GDIM, BID);
                      EpiF4<FInProj> E{FInProj{WSP(bf16, WS_P), fresh(a).out, l, WSP(const float, WS_ROPE)}}; pg8::gemm_phase<EpiF4<FInProj>, pg8::StaticOrder, true, true>(glds, g, S, E); } break;
            case 1: phase_mixprep(fresh(a), l, (float*)fresh_lds(lds)); phase_gla_local(fresh(a), l, fresh_lds(lds)); break;
            case 2: phase_gla_scan(fresh(a), l); phase_attn(fresh(a), l, fresh_lds(lds)); break;
            case 3: phase_gla_out(fresh(a), l, fresh_lds(lds)); break;
            case 4: { pg8::Gemm g{WSP(const bf16, WS_MIX), WSP(const bf16, WS_WOUT_T) + (size_t)l * D * D, NTOK, D, D}; pg8::StaticOrder S; S.init(NTOK, D, GDIM, BID);
                      EpiF4<FResid> E{FResid{WSP(float, WS_X), l == 0 ? a.in[I_XP] : WSP(const float, WS_X), l == 0 ? a.in[I_XS] : WSP(const float, WS_X) + (size_t)NCTX * D, MODL, 2 * D}}; pg8::gemm_phase<EpiF4<FResid>, pg8::StaticOrder, false, true>(glds, g, S, E); } break;
            case 5: phase_norm(WSP(const float, WS_X), nullptr, a.in[I_N2] + l * D, MODL, 3 * D, 4 * D, WSP(bf16, WS_H)); break;
            case 6: { pg8::Gemm g{WSP(const bf16, WS_H), WSP(const bf16, WS_WQ_T) + (size_t)l * D * D, NTOK, D, D}; pg8::StaticOrder S; S.init(NTOK, D, GDIM, BID);
                      EpiF4<FStore> E{FStore{WSP(bf16, WS_Q)}}; pg8::gemm_phase<EpiF4<FStore>, pg8::StaticOrder, false, true>(glds, g, S, E); } phase_cvt_tables(fresh(a), l); break;
            default: phase_peer(fresh(a), l, fresh_lds(lds)); break;
            }
        }
        if (step != NSTEP - 1) xcd_barrier(bar);
    }
}


extern "C" void kernel_launch(void* const* d_in, const int* in_sizes, int n_in, void* d_out, int out_size, void* d_ws, size_t ws_size, hipStream_t stream) {
    static int grid = 0;
    if (grid == 0) {
        if (n_in != 27 || ws_size < WS_END) { fprintf(stderr, "kernel_launch: unexpected n_in %d / ws %zu\n", n_in, ws_size); grid = -1; return; }
        int dev = 0, cus = 0;
        if (hipGetDevice(&dev) != hipSuccess || hipDeviceGetAttribute(&cus, hipDeviceAttributeMultiprocessorCount, dev) != hipSuccess) { grid = -1; return; }
        if (hipFuncSetAttribute((const void*)mega_fwd, hipFuncAttributeMaxDynamicSharedMemorySize, LDS_BYTES) != hipSuccess) { fprintf(stderr, "kernel_launch: hipFuncSetAttribute failed\n"); grid = -1; return; }
        int per_cu = 0;
        if (hipOccupancyMaxActiveBlocksPerMultiprocessor(&per_cu, (const void*)mega_fwd, NT, LDS_BYTES) != hipSuccess || per_cu < 1) fprintf(stderr, "kernel_launch: occupancy query says %d\n", per_cu);
        (void)hipGetLastError();
        grid = cus;
    }
    if (grid < 0) return;
    if (hipMemsetAsync((char*)d_ws + WS_CTL, 0, CTL_ZERO_BYTES, stream) != hipSuccess) return;
    KArgs a{};
    for (int i = 0; i < 27; ++i) a.in[i] = (const float*)d_in[i];
    a.out = (float*)d_out; a.ws = (unsigned char*)d_ws;
    hipLaunchKernelGGL(mega_fwd, dim3(grid), dim3(NT), LDS_BYTES, stream, a);
}
```

```cpp
#include <hip/hip_runtime.h>
#include <cstdio>
#include <cstdint>

#define LAS __attribute__((address_space(3)))
#define RLX_AGENT __ATOMIC_RELAXED, __HIP_MEMORY_SCOPE_AGENT

constexpr int D = 1024, NTOK = 16384, NCTX = 8192, NLAYER = 4;
constexpr int INW = 1824;
constexpr int C_POOL = 0, C_GQ = 256, C_GK = 384, C_GV = 512, C_GG = 768, C_ZF = 1024, C_ZB = 1040, C_AQ = 1056, C_AK = 1568, C_AV = 1696;
constexpr int NT = 512, NWAVES = 8;
constexpr int LDS_BYTES = 147456;
constexpr float EPS = 1e-6f;

constexpr size_t MiB = 1u << 20;
constexpr size_t WS_CTL = 0, CTL_ZERO_BYTES = 1 * MiB;
constexpr size_t WS_MOD = 1 * MiB;
constexpr size_t WS_WIN_T = 2 * MiB;
constexpr size_t WS_WOUT_T = 18 * MiB;
constexpr size_t WS_WQ_T = 26 * MiB;
constexpr size_t WS_X = 64 * MiB;
constexpr size_t WS_H = 128 * MiB;
constexpr size_t WS_P = 192 * MiB;
constexpr size_t WS_MIX = 320 * MiB;
constexpr size_t WS_DS = 384 * MiB;
constexpr size_t WS_SST = 400 * MiB;
constexpr size_t WS_DEC = 416 * MiB;
constexpr size_t WS_Q = 448 * MiB;
constexpr size_t WS_EXP = 528 * MiB;
constexpr size_t WS_GATE = 536 * MiB;
constexpr size_t WS_U8 = 544 * MiB;
constexpr size_t WS_V8 = 608 * MiB;
constexpr size_t WS_SUV = 672 * MiB;
constexpr size_t WS_ROPE = 673 * MiB;
constexpr size_t WS_SKB = 674 * MiB;
constexpr size_t WS_END = 676 * MiB;
constexpr int CW_BAR = 4096;

#define XB_TMO      128
#define XB_XCNT(j)  (256  + 64 * (j))
#define XB_XSUB(j)  (1280 + 64 * (j))
#define XB_XGEN(j)  (2304 + 64 * (j))
#define XB_TOP      3328
#define XB_TOPGEN   3392
#define XCD_BAR_WORDS 3456
#define XB_SPIN_CAP (1u << 23)

__device__ __forceinline__ unsigned xb_ld(unsigned* p)              { return __hip_atomic_load(p, __ATOMIC_RELAXED, __HIP_MEMORY_SCOPE_AGENT); }
__device__ __forceinline__ unsigned xb_add(unsigned* p, unsigned v) { return __hip_atomic_fetch_add(p, v, __ATOMIC_RELAXED, __HIP_MEMORY_SCOPE_AGENT); }
__device__ __forceinline__ unsigned xb_xcc_id() { return (unsigned)__builtin_amdgcn_s_getreg((3 << 11) | 20) & 0xFu; }
#define XB_SPIN(cond, bar) do { unsigned _sp = 0; while (cond) { __builtin_amdgcn_s_sleep(1); \
    if ((++_sp & 255u) == 0u) { if (xb_ld(&(bar)[XB_TMO])) break; if (_sp > XB_SPIN_CAP) { atomicAdd(&(bar)[XB_TMO], 1u); break; } } } } while (0)

struct XcdBarrier { unsigned* bar; unsigned x; volatile LAS unsigned* st; };

__device__ __forceinline__ XcdBarrier xcd_barrier_post(unsigned* bar, volatile LAS unsigned* st) {
    XcdBarrier b; b.bar = bar; b.x = xb_xcc_id(); b.st = st;
    if (threadIdx.x == 0) (void)xb_add(&bar[XB_XCNT(b.x)], 1u);
    return b;
}
__device__ __forceinline__ void xcd_barrier_complete(unsigned* bar, unsigned x, unsigned& nloc, unsigned& nx) {
    const unsigned G = gridDim.x * gridDim.y * gridDim.z;
    unsigned sum, cnt, mine, sp = 0u;
    for (;;) {
        sum = 0u; cnt = 0u; mine = 0u;
#pragma unroll
        for (unsigned j = 0; j < 16; ++j) { const unsigned c = xb_ld(&bar[XB_XCNT(j)]); sum += c; cnt += (c > 0u) ? 1u : 0u; mine = (j == x) ? c : mine; }
        if (sum == G) break;
        __builtin_amdgcn_s_sleep(1);
        if ((++sp & 255u) == 0u) { if (xb_ld(&bar[XB_TMO])) break; if (sp > XB_SPIN_CAP) { atomicAdd(&bar[XB_TMO], 1u); break; } }
    }
    nloc = mine > 0u ? mine : 1u; nx = cnt > 0u ? cnt : 1u;
}
__device__ __forceinline__ void xcd_barrier(const XcdBarrier& b) {
    asm volatile("s_waitcnt vmcnt(0)" ::: "memory");
    __syncthreads();
    if (threadIdx.x == 0) {
        unsigned* bar = b.bar; asm volatile("" : "+s"(bar));
        __builtin_amdgcn_s_waitcnt(0);
        unsigned nloc = b.st[0], nx = b.st[1]; unsigned bx = b.x; asm volatile("" : "+s"(bx));
        if (nloc == 0u) { xcd_barrier_complete(bar, bx, nloc, nx); b.st[0] = nloc; b.st[1] = nx; }
        const unsigned old = xb_add(&bar[XB_XSUB(bx)], 1u);
        const unsigned gen = old / nloc;
        if (old + 1u == (gen + 1u) * nloc) {
            __builtin_amdgcn_fence(__ATOMIC_RELEASE, "agent");
            asm volatile("s_waitcnt vmcnt(0)" ::: "memory");
            const unsigned og = xb_add(&bar[XB_TOP], 1u);
            const unsigned tg = og / nx;
            if (og + 1u == (tg + 1u) * nx) xb_add(&bar[XB_TOPGEN], 1u);
            else XB_SPIN(xb_ld(&bar[XB_TOPGEN]) == tg, bar);
            __builtin_amdgcn_fence(__ATOMIC_ACQUIRE, "agent");
            xb_add(&bar[XB_XGEN(bx)], 1u);
            asm volatile("s_waitcnt vmcnt(0)" ::: "memory");
        } else {
            XB_SPIN(xb_ld(&bar[XB_XGEN(bx)]) == gen, bar);
            __builtin_amdgcn_fence(__ATOMIC_ACQUIRE, "agent");
            asm volatile("s_waitcnt vmcnt(0)" ::: "memory");
        }
    }
    __syncthreads();
}

typedef float f32x4 __attribute__((ext_vector_type(4)));
__device__ __forceinline__ float wave_sum(float v) {
#pragma unroll
    for (int o = 1; o < 64; o <<= 1) v += __shfl_xor(v, o);
    return v;
}
template <int CTRL> __device__ __forceinline__ float dpp_mov(float x) { return __builtin_bit_cast(float, __builtin_amdgcn_update_dpp(0, __builtin_bit_cast(int, x), CTRL, 0xf, 0xf, true)); }
__device__ __forceinline__ float wave_sum_u(float x) {
    x += dpp_mov<0xB1>(x);
    x += dpp_mov<0x4E>(x);
    x += dpp_mov<0x141>(x);
    x += dpp_mov<0x140>(x);
    const int xi = __builtin_bit_cast(int, x);
    const float s0 = __builtin_bit_cast(float, __builtin_amdgcn_readlane(xi, 0)), s1 = __builtin_bit_cast(float, __builtin_amdgcn_readlane(xi, 16));
    const float s2 = __builtin_bit_cast(float, __builtin_amdgcn_readlane(xi, 32)), s3 = __builtin_bit_cast(float, __builtin_amdgcn_readlane(xi, 48));
    return (s0 + s1) + (s2 + s3);
}
__device__ __forceinline__ float wave_max_u(float x) {
    x = fmaxf(x, dpp_mov<0xB1>(x)); x = fmaxf(x, dpp_mov<0x4E>(x)); x = fmaxf(x, dpp_mov<0x141>(x)); x = fmaxf(x, dpp_mov<0x140>(x));
    const int xi = __builtin_bit_cast(int, x);
    const float s0 = __builtin_bit_cast(float, __builtin_amdgcn_readlane(xi, 0)), s1 = __builtin_bit_cast(float, __builtin_amdgcn_readlane(xi, 16));
    const float s2 = __builtin_bit_cast(float, __builtin_amdgcn_readlane(xi, 32)), s3 = __builtin_bit_cast(float, __builtin_amdgcn_readlane(xi, 48));
    return fmaxf(fmaxf(s0, s1), fmaxf(s2, s3));
}
__device__ __forceinline__ float wave_prefix_incl(float x, int lane) {
    x += dpp_mov<0x111>(x); x += dpp_mov<0x112>(x); x += dpp_mov<0x114>(x); x += dpp_mov<0x118>(x);
    const int xi = __builtin_bit_cast(int, x);
    const float t0 = __builtin_bit_cast(float, __builtin_amdgcn_readlane(xi, 15)), t1 = __builtin_bit_cast(float, __builtin_amdgcn_readlane(xi, 31)), t2 = __builtin_bit_cast(float, __builtin_amdgcn_readlane(xi, 47));
    return x + (lane >= 48 ? (t0 + t1) + t2 : lane >= 32 ? t0 + t1 : lane >= 16 ? t0 : 0.f);
}
__device__ __forceinline__ float wave_suffix_incl(float x, int lane) {
    x += dpp_mov<0x101>(x); x += dpp_mov<0x102>(x); x += dpp_mov<0x104>(x); x += dpp_mov<0x108>(x);
    const int xi = __builtin_bit_cast(int, x);
    const float r1 = __builtin_bit_cast(float, __builtin_amdgcn_readlane(xi, 16)), r2 = __builtin_bit_cast(float, __builtin_amdgcn_readlane(xi, 32)), r3 = __builtin_bit_cast(float, __builtin_amdgcn_readlane(xi, 48));
    return x + (lane < 16 ? (r1 + r2) + r3 : lane < 32 ? r2 + r3 : lane < 48 ? r3 : 0.f);
}
__device__ __forceinline__ float log_sigmoid_fast(float x) { return fminf(x, 0.f) - __logf(1.f + __expf(-fabsf(x))); }
__device__ __forceinline__ int lv(int v) { asm volatile("" : "+v"(v)); return v; }
__device__ __forceinline__ int ls(int v) { asm volatile("" : "+s"(v)); return v; }
#define TID lv((int)threadIdx.x)
#define BID ls((int)blockIdx.x)
#define GDIM ls((int)gridDim.x)
__device__ __forceinline__ int grp_of(int t) { return t < NCTX ? 0 : 1 + ((t - NCTX) >> 12); }
__device__ __forceinline__ float siluf(float x) { return x * __builtin_amdgcn_rcpf(1.f + __expf(-x)); }

struct KArgs { const float* in[27]; float* out; unsigned char* ws; };
struct InTab { volatile LAS unsigned* t; unsigned char* ws;
    __device__ __forceinline__ const float* operator[](int i) const {
        unsigned off = 8u * (unsigned)i; asm volatile("" : "+v"(off));
        volatile LAS unsigned* e = (volatile LAS unsigned*)((LAS unsigned char*)t + off);
        const unsigned lo = __builtin_amdgcn_readfirstlane(e[0]), hi = __builtin_amdgcn_readfirstlane(e[1]);
        return (const float*)(ws + (long long)(((unsigned long long)hi << 32) | lo)); } };
struct Args { InTab in; float* out; unsigned char* ws; };
#define GAS __attribute__((address_space(1)))
__device__ __forceinline__ Args fresh(const Args& a) {
    GAS float* o = (GAS float*)a.out; GAS unsigned char* w = (GAS unsigned char*)a.ws;
    asm volatile("" : "+s"(o)); asm volatile("" : "+s"(w));
    Args b = a; b.out = (float*)o; b.ws = (unsigned char*)w; b.in.ws = b.ws; return b; }
__device__ __forceinline__ unsigned char* fresh_lds(unsigned char* p) { LAS unsigned char* q = (LAS unsigned char*)p; asm volatile("" : "+s"(q)); return (unsigned char*)q; }
enum { I_XP = 0, I_XS, I_CK, I_CV, I_SF, I_SB, I_C, I_CCTX, I_WADA, I_BADA, I_N1, I_N2, I_WIN, I_POOLW, I_POOLS, I_GWF, I_GBF, I_GWB, I_GBB, I_GNORM, I_SINK, I_WOUT, I_WQ, I_SUBK, I_PU, I_PV, I_FNORM };
constexpr size_t OUT_YP = 0, OUT_YS = 8388608, OUT_CK = 16777216, OUT_CV = 20971520, OUT_SF = 25165824, OUT_SB = 26214400;


namespace pg8 {
#define PG8_LAS __attribute__((address_space(3)))
typedef unsigned short bf16_t;
typedef short bf16x8 __attribute__((ext_vector_type(8)));
typedef float f32x4 __attribute__((ext_vector_type(4)));
typedef unsigned u32x4 __attribute__((ext_vector_type(4)));
constexpr int BM = 256, BK = 64, HALF = 128, HTB = HALF * BK * 2  , STAGE_BYTES = 8 * HTB, NXCD = 8, WGM = 8;

__host__ __device__ __forceinline__ int lds_byte(int r, int c) { const int st = (r >> 4) * 2 + (c >> 5), rr = r & 15, cc = c & 31, ob = rr * 64 + cc * 2; return st * 1024 + (ob ^ (((ob >> 9) & 1) << 5)); }
__host__ __device__ __forceinline__ void stage_rc(int b, int& R, int& C) { const int st = b / 1024, sb = b % 1024, swz = sb ^ (((sb >> 9) & 1) << 5); R = (st >> 1) * 16 + swz / 64; C = (st & 1) * 32 + (swz % 64) / 2; }
__host__ __device__ __forceinline__ int perm32(int rho) { const int n = rho >> 4, i = rho & 15; return 8 * (i >> 2) + 4 * n + (i & 3); }

struct Unit { int pm, pn; };
struct Gemm { const bf16_t* A; const bf16_t* Bt; int M, N, K; };

struct StaticOrder {
    int nM, nN, nwg, G, c;
    __host__ __device__ void init(int M, int N, int G_, int c_) { nM = M / BM; nN = N / BM; nwg = nM * nN; G = G_; c = c_; }
    __host__ __device__ bool next(int i, Unit& u) const {
        const long L = (long)i * G + c; if (L >= nwg) return false;
        int wgid = (int)L; { const int q = nwg / NXCD, r = nwg % NXCD, xcd = wgid % NXCD, off = wgid / NXCD; wgid = (xcd < r ? xcd * (q + 1) : r * (q + 1) + (xcd - r) * q) + off; }
        const int nig = WGM * nN, gid = wgid / nig, fm = gid * WGM, gsz = (nM - fm) < WGM ? (nM - fm) : WGM;
        u.pm = fm + ((wgid % nig) % gsz); u.pn = (wgid % nig) / gsz; return true;
    }
    __device__ __forceinline__ void a_ready(const Unit&) const {}
    __device__ __forceinline__ void done(const Unit&) const {}
};

__device__ __forceinline__ unsigned cvt_pk_bf16(float lo, float hi) { unsigned r; asm volatile("v_cvt_pk_bf16_f32 %0, %1, %2" : "=v"(r) : "v"(lo), "v"(hi)); return r; }
typedef float f32x2 __attribute__((ext_vector_type(2)));
__device__ __forceinline__ f32x2 gelu_pk(f32x2 v) {
    const f32x2 av = __builtin_elementwise_abs(v), d = av * 0.2316418882f + 1.0f;
    f32x2 t; t.x = __builtin_amdgcn_rcpf(d.x); t.y = __builtin_amdgcn_rcpf(d.y);
    f32x2 q = t * 0.5307027145f + (-0.7265760135f); q = q * t + 0.7107068705f; q = q * t + (-0.142248368f); q = q * t + 0.127414796f; q = q * t;
    const f32x2 s = (v * v) * (-0.72134752044f);
    f32x2 e; e.x = __builtin_amdgcn_exp2f(s.x); e.y = __builtin_amdgcn_exp2f(s.y);
    const f32x2 m = v * (q * e), r = v - m;
    f32x2 o; o.x = v.x < 0.f ? m.x : r.x; o.y = v.y < 0.f ? m.y : r.y; return o;
}

template <int ACT  > struct EpiBf16 {
    static constexpr bool PERM = true, AFTER_DRAIN = false; static_assert(ACT == 0 || ACT == 1, "EpiBf16: ACT is 0 (none) or 1 (gelu_pk)");
    bf16_t* O; int ldc; const float* bias; int split_cols; size_t split_stride; float scale0;
    __device__ __forceinline__ void operator()(const f32x4 (&acc)[2][2][4][2], const Unit& u, int wr, int wc, int fr, int fq) const {
        const int row0 = u.pm * BM + wr * 64 + fr; int colt = u.pn * BM; bf16_t* base = O;
        float sc = 1.f; if (split_cols) { const int t = colt / split_cols; base += (size_t)t * split_stride; colt -= t * split_cols; if (t == 0) sc = scale0; }
        const int col0 = colt + wc * 32 + 8 * fq, bcol0 = u.pn * BM + wc * 32 + 8 * fq;
        f32x4 bv[2][2];
#pragma unroll
        for (int bj = 0; bj < 2; ++bj)
#pragma unroll
            for (int n = 0; n < 2; ++n) bv[bj][n] = bias ? *(const f32x4*)(bias + bcol0 + bj * HALF + 4 * n) : (f32x4){0.f, 0.f, 0.f, 0.f};
#pragma unroll
        for (int ai = 0; ai < 2; ++ai)
#pragma unroll
            for (int m = 0; m < 4; ++m) { bf16_t* rowp = base + (size_t)(row0 + ai * HALF + m * 16) * ldc + col0;
#pragma unroll
                for (int bj = 0; bj < 2; ++bj) { f32x4 v0 = acc[ai][bj][m][0] + bv[bj][0], v1 = acc[ai][bj][m][1] + bv[bj][1];
                    if (ACT == 1) { f32x2 a = gelu_pk((f32x2){v0[0], v0[1]}), b = gelu_pk((f32x2){v0[2], v0[3]}), c = gelu_pk((f32x2){v1[0], v1[1]}), d = gelu_pk((f32x2){v1[2], v1[3]});
                        v0 = (f32x4){a.x, a.y, b.x, b.y}; v1 = (f32x4){c.x, c.y, d.x, d.y}; }
                    v0 = v0 * sc; v1 = v1 * sc; u32x4 w; w.x = cvt_pk_bf16(v0[0], v0[1]); w.y = cvt_pk_bf16(v0[2], v0[3]); w.z = cvt_pk_bf16(v1[0], v1[1]); w.w = cvt_pk_bf16(v1[2], v1[3]);
                    *(u32x4*)(rowp + bj * HALF) = w; } }
    }
};

struct PanelStats {
    unsigned* xbuf;
    unsigned* cnt;
    unsigned* tmo;
    int ntn; float eps;
    unsigned code;
    __device__ __forceinline__ bool run(const f32x4 (&v)[2][2][4][2], const Unit& u, int wr, int wc, int fr, int fq, PG8_LAS unsigned char* lds, int wid, int lane) const {
        typedef float f32x2v __attribute__((ext_vector_type(2)));
        PG8_LAS f32x2v* P = (PG8_LAS f32x2v*)lds;
        PG8_LAS f32x2v* S = (PG8_LAS f32x2v*)(lds + 8192);
        PG8_LAS unsigned* flag = (PG8_LAS unsigned*)(lds + 8192 + 2048);
#pragma unroll
        for (int ai = 0; ai < 2; ++ai)
#pragma unroll
            for (int m = 0; m < 4; ++m) {
                float s = 0.f;
#pragma unroll
                for (int bj = 0; bj < 2; ++bj)
#pragma unroll
                    for (int n = 0; n < 2; ++n) { const f32x4 x = v[ai][bj][m][n]; s += (x[0] + x[1]) + (x[2] + x[3]); }
                s += __shfl_xor(s, 16); s += __shfl_xor(s, 32);
                const float mw = s * (1.0f / 64.0f); float q = 0.f;
#pragma unroll
                for (int bj = 0; bj < 2; ++bj)
#pragma unroll
                    for (int n = 0; n < 2; ++n) { const f32x4 d = v[ai][bj][m][n] - mw; q += (d[0] * d[0] + d[1] * d[1]) + (d[2] * d[2] + d[3] * d[3]); }
                q += __shfl_xor(q, 16); q += __shfl_xor(q, 32);
                if (fq == 0) P[(ai * HALF + wr * 64 + m * 16 + fr) * 4 + wc] = (f32x2v){mw, q};
            }
        asm volatile("s_waitcnt lgkmcnt(0)" ::: "memory"); __builtin_amdgcn_s_barrier(); asm volatile("" ::: "memory");
        const int row = wid * 32 + (lane & 31);
        if (lane < 32) {
            const f32x2v a = P[row * 4 + 0], b = P[row * 4 + 1], c = P[row * 4 + 2], d = P[row * 4 + 3];
            const float mt = (a.x + b.x + c.x + d.x) * 0.25f;
            const float da = a.x - mt, db = b.x - mt, dc = c.x - mt, dd = d.x - mt;
            const float m2 = (a.y + b.y) + (c.y + d.y) + 64.0f * ((da * da + db * db) + (dc * dc + dd * dd));
            unsigned long long* slot = (unsigned long long*)xbuf + ((size_t)(u.pm * BM + row) * 4 + u.pn);
            __hip_atomic_store(slot, ((unsigned long long)__float_as_uint(m2) << 32) | __float_as_uint(mt), __ATOMIC_RELAXED, __HIP_MEMORY_SCOPE_AGENT);
        }
        asm volatile("s_waitcnt vmcnt(0)" ::: "memory");
        if (lane == 0) __hip_atomic_fetch_add(cnt + 64 * u.pm, 1u, __ATOMIC_RELAXED, __HIP_MEMORY_SCOPE_AGENT);
        if (wid == 0) {
            bool dead = false; const unsigned long long t0 = __builtin_amdgcn_s_memrealtime(); const unsigned want = 8u * (unsigned)ntn;
            for (;;) {
                if ((unsigned)__builtin_amdgcn_readfirstlane(__hip_atomic_load(cnt + 64 * u.pm, __ATOMIC_RELAXED, __HIP_MEMORY_SCOPE_AGENT)) >= want) break;
                if (__builtin_amdgcn_s_memrealtime() - t0 > 2000000ull) {
                    if (lane == 0) { unsigned expect = 0u; __hip_atomic_compare_exchange_strong(tmo + 1, &expect, code | (unsigned)(u.pm & 0xff), __ATOMIC_RELAXED, __ATOMIC_RELAXED, __HIP_MEMORY_SCOPE_AGENT);
                                     __hip_atomic_store(tmo, 1u, __ATOMIC_RELAXED, __HIP_MEMORY_SCOPE_AGENT); }
                    dead = true; break; }
                __builtin_amdgcn_s_sleep(2);
            }
            __builtin_amdgcn_fence(__ATOMIC_ACQUIRE, "agent");
            if (lane == 0) flag[0] = dead ? 1u : 0u;
        }
        asm volatile("s_waitcnt vmcnt(0) lgkmcnt(0)" ::: "memory"); __builtin_amdgcn_s_barrier(); asm volatile("" ::: "memory");
        const bool bad = flag[0] != 0u;
        if (lane < 32) {
            const unsigned long long* slot = (const unsigned long long*)xbuf + (size_t)(u.pm * BM + row) * 4; float mt[4], m2[4]; float ms = 0.f;
#pragma unroll
            for (int t = 0; t < 4; ++t) { if (t < ntn) { const unsigned long long w = __hip_atomic_load(slot + t, __ATOMIC_RELAXED, __HIP_MEMORY_SCOPE_AGENT); mt[t] = __uint_as_float((unsigned)w); m2[t] = __uint_as_float((unsigned)(w >> 32)); } else { mt[t] = 0.f; m2[t] = 0.f; } ms += mt[t]; }
            const float mean = ms / (float)ntn; float q = 0.f;
#pragma unroll
            for (int t = 0; t < 4; ++t) if (t < ntn) { const float dm = mt[t] - mean; q += m2[t] + 256.0f * dm * dm; }
            S[row] = (f32x2v){mean, 1.0f / sqrtf(q / (256.0f * (float)ntn) + eps)};
        }
        asm volatile("s_waitcnt lgkmcnt(0)" ::: "memory"); __builtin_amdgcn_s_barrier(); asm volatile("" ::: "memory");
        return bad;
    }
};
struct EpiLnRes {
    static constexpr bool PERM = false, AFTER_DRAIN = true;
    const float* base; float* out; int ldc; const float* bias; PanelStats st; unsigned poison;
    __device__ __forceinline__ void fused(f32x4 (&acc)[2][2][4][2], const Unit& u, int wr, int wc, int fr, int fq, PG8_LAS unsigned char* lds, int wid, int lane) const {
        typedef float f32x2v __attribute__((ext_vector_type(2)));
        const PG8_LAS f32x2v* S = (const PG8_LAS f32x2v*)(lds + 8192);
        const int col0 = u.pn * BM + wc * 32 + 4 * fq;
#pragma unroll
        for (int bj = 0; bj < 2; ++bj)
#pragma unroll
            for (int n = 0; n < 2; ++n) { const f32x4 bv = bias ? *(const f32x4*)(bias + col0 + bj * HALF + n * 16) : (f32x4){0.f, 0.f, 0.f, 0.f};
#pragma unroll
                for (int ai = 0; ai < 2; ++ai)
#pragma unroll
                    for (int m = 0; m < 4; ++m) acc[ai][bj][m][n] += bv; }
        f32x4 pre[4][2][2];
#pragma unroll
        for (int m = 0; m < 4; ++m) { const size_t off = (size_t)(u.pm * BM + wr * 64 + m * 16 + fr) * ldc + col0;
#pragma unroll
            for (int bj = 0; bj < 2; ++bj)
#pragma unroll
                for (int n = 0; n < 2; ++n) pre[m][bj][n] = *(const f32x4*)(base + off + bj * HALF + n * 16); }
        const bool bad = st.run(acc, u, wr, wc, fr, fq, lds, wid, lane) || poison != 0u;
        const float qnan = __builtin_nanf("");
#pragma unroll
        for (int ai = 0; ai < 2; ++ai)
#pragma unroll
            for (int m = 0; m < 4; ++m) { const int r = ai * HALF + wr * 64 + m * 16 + fr; const f32x2v sr = S[r]; const size_t off = (size_t)(u.pm * BM + r) * ldc + col0;
#pragma unroll
                for (int bj = 0; bj < 2; ++bj)
#pragma unroll
                    for (int n = 0; n < 2; ++n) { const f32x4 bs = ai == 0 ? pre[m][bj][n] : *(const f32x4*)(base + off + bj * HALF + n * 16); f32x4 o = bs + (acc[ai][bj][m][n] - sr.x) * sr.y;
                        if (bad) o = (f32x4){qnan, qnan, qnan, qnan}; *(f32x4*)(out + off + bj * HALF + n * 16) = o; }
                if (m & 1) asm volatile("" ::: "memory"); }
    }
};
struct EpiLnResLn {
    static constexpr bool PERM = false, AFTER_DRAIN = true;
    const float* base; float* out; bf16_t* xn; int ldc; const float* bias; PanelStats st1, st2; unsigned poison;
    __device__ __forceinline__ void fused(f32x4 (&acc)[2][2][4][2], const Unit& u, int wr, int wc, int fr, int fq, PG8_LAS unsigned char* lds, int wid, int lane) const {
        typedef float f32x2v __attribute__((ext_vector_type(2))); typedef unsigned u32x2v __attribute__((ext_vector_type(2)));
        const PG8_LAS f32x2v* S = (const PG8_LAS f32x2v*)(lds + 8192);
        const int col0 = u.pn * BM + wc * 32 + 4 * fq;
#pragma unroll
        for (int bj = 0; bj < 2; ++bj)
#pragma unroll
            for (int n = 0; n < 2; ++n) { const f32x4 bv = bias ? *(const f32x4*)(bias + col0 + bj * HALF + n * 16) : (f32x4){0.f, 0.f, 0.f, 0.f};
#pragma unroll
                for (int ai = 0; ai < 2; ++ai)
#pragma unroll
                    for (int m = 0; m < 4; ++m) acc[ai][bj][m][n] += bv; }
        bool bad = st1.run(acc, u, wr, wc, fr, fq, lds, wid, lane) || poison != 0u;
        const float qnan = __builtin_nanf("");
#pragma unroll
        for (int ai = 0; ai < 2; ++ai)
#pragma unroll
            for (int m = 0; m < 4; ++m) { const int r = ai * HALF + wr * 64 + m * 16 + fr; const f32x2v sr = S[r]; const size_t off = (size_t)(u.pm * BM + r) * ldc + col0;
#pragma unroll
                for (int bj = 0; bj < 2; ++bj)
#pragma unroll
                    for (int n = 0; n < 2; ++n) { const f32x4 bs = *(const f32x4*)(base + off + bj * HALF + n * 16); acc[ai][bj][m][n] = bs + (acc[ai][bj][m][n] - sr.x) * sr.y; }
                asm volatile("" : "+v"(acc[ai][0][m][0]), "+v"(acc[ai][0][m][1]), "+v"(acc[ai][1][m][0]), "+v"(acc[ai][1][m][1]));
                if (m & 1) asm volatile("" ::: "memory"); }
        const bool bad1 = bad;
        bad = st2.run(acc, u, wr, wc, fr, fq, lds, wid, lane) || bad;
#pragma unroll
        for (int ai = 0; ai < 2; ++ai)
#pragma unroll
            for (int m = 0; m < 4; ++m) { const int r = ai * HALF + wr * 64 + m * 16 + fr; const f32x2v sr = S[r]; const size_t off = (size_t)(u.pm * BM + r) * ldc + col0;
#pragma unroll
                for (int bj = 0; bj < 2; ++bj)
#pragma unroll
                    for (int n = 0; n < 2; ++n) { const f32x4 x1 = acc[ai][bj][m][n]; *(f32x4*)(out + off + bj * HALF + n * 16) = bad1 ? (f32x4){qnan, qnan, qnan, qnan} : x1;
                        const f32x4 o = (x1 - sr.x) * sr.y; u32x2v w; w.x = cvt_pk_bf16(o[0], o[1]); w.y = cvt_pk_bf16(o[2], o[3]);
                        if (bad) { w.x = 0x7fc07fc0u; w.y = 0x7fc07fc0u; } *(u32x2v*)(xn + off + bj * HALF + n * 16) = w; }
                asm volatile("" ::: "memory"); }
    }
};

template <class Epi, class Sched, bool ALIGN_EPI = false, bool SP2 = false>
__device__ __forceinline__ void gemm_phase(PG8_LAS unsigned char* lds, const Gemm g, const Sched& S, const Epi& E) {
    int tid = threadIdx.x; asm volatile("" : "+v"(tid));
    const int wid = __builtin_amdgcn_readfirstlane(tid >> 6), lane = tid & 63, wr = wid >> 2, wc = wid & 3, fr = lane & 15, fq = lane >> 4;
    const int K = g.K, nt = K / BK;
    unsigned voffA[2], voffB[2];
#pragma unroll
    for (int i = 0; i < 2; ++i) { int R, C; stage_rc(tid * 16 + i * 8192, R, C); const int Rb = Epi::PERM ? ((R & ~31) + perm32(R & 31)) : R;
        voffA[i] = (unsigned)(R * K + C) * 2u; voffB[i] = (unsigned)(Rb * K + C) * 2u; }
    const size_t kstep = (size_t)(BK * 2);
    const size_t hstep = (size_t)HALF * K * 2;
    const size_t tstep = 2 * hstep;
    const unsigned ldsw = (unsigned)wid * 1024u;
    const int aoff = lds_byte(wr * 64 + fr, fq * 8), boff = lds_byte(wc * 32 + fr, fq * 8);
#define PG8_SA(b, h) (((b) * 2 + (h)) * HTB)
#define PG8_SB(b, h) ((4 + (b) * 2 + (h)) * HTB)
#define PG8_STAGE(bufoff, gbase, voff) do { _Pragma("unroll") for (int _i = 0; _i < 2; ++_i) \
        __builtin_amdgcn_global_load_lds((const unsigned*)((const char*)(gbase) + (voff)[_i]), (PG8_LAS unsigned*)(lds + (bufoff) + ldsw + _i * 8192), 16, 0, 0); } while (0)
#define PG8_LDA(dst, b, h) do { _Pragma("unroll") for (int m = 0; m < 4; ++m) _Pragma("unroll") for (int k = 0; k < 2; ++k) dst[m][k] = *(const PG8_LAS bf16x8*)(lds + PG8_SA(b, h) + aoff + m * 2048 + k * 1024); } while (0)
#define PG8_LDB(dst, b, h) do { _Pragma("unroll") for (int n = 0; n < 2; ++n) _Pragma("unroll") for (int k = 0; k < 2; ++k) dst[n][k] = *(const PG8_LAS bf16x8*)(lds + PG8_SB(b, h) + boff + n * 2048 + k * 1024); } while (0)
#define PG8_MMA(ai, bj, At, Bt) do { __builtin_amdgcn_s_setprio(1); _Pragma("unroll") for (int m = 0; m < 4; ++m) _Pragma("unroll") for (int n = 0; n < 2; ++n) _Pragma("unroll") for (int k = 0; k < 2; ++k) \
        acc[ai][bj][m][n] = __builtin_amdgcn_mfma_f32_16x16x32_bf16(Bt[n][k], At[m][k], acc[ai][bj][m][n], 0, 0, 0); __builtin_amdgcn_s_setprio(0); } while (0)
#define PG8_WAIT_V(n) asm volatile("s_waitcnt vmcnt(" #n ")" ::: "memory")
#define PG8_WAIT_L(n) asm volatile("s_waitcnt lgkmcnt(" #n ")" ::: "memory")
#define PG8_BAR __builtin_amdgcn_s_barrier()
#define PG8_SCHED __builtin_amdgcn_sched_barrier(0)
    Unit cur, nxt; int ui = 0;
    if (!S.next(0, cur)) return;
    f32x4 acc[2][2][4][2];
#pragma unroll
    for (int a = 0; a < 2; ++a)
#pragma unroll
        for (int b = 0; b < 2; ++b)
#pragma unroll
            for (int m = 0; m < 4; ++m)
#pragma unroll
                for (int n = 0; n < 2; ++n) acc[a][b][m][n] = (f32x4){0.f, 0.f, 0.f, 0.f};
    bf16x8 At[4][2], B0[2][2], B1[2][2];
    const char* cA = (const char*)g.A + (size_t)cur.pm * tstep; const char* cB = (const char*)g.Bt + (size_t)cur.pn * tstep;
    S.a_ready(cur);
    if constexpr (SP2) {
        PG8_STAGE(PG8_SB(0, 0), cB, voffB); PG8_STAGE(PG8_SB(0, 1), cB + hstep, voffB); PG8_STAGE(PG8_SA(0, 0), cA, voffA); PG8_STAGE(PG8_SA(0, 1), cA + hstep, voffA);
        if (wr == 1) PG8_BAR;
        PG8_WAIT_V(2); PG8_BAR;
        PG8_STAGE(PG8_SB(1, 0), cB + kstep, voffB); PG8_STAGE(PG8_SA(1, 0), cA + kstep, voffA); PG8_STAGE(PG8_SB(1, 1), cB + hstep + kstep, voffB);
        PG8_WAIT_V(6); PG8_BAR;
    } else {
        PG8_STAGE(PG8_SB(0, 0), cB, voffB); PG8_STAGE(PG8_SA(0, 0), cA, voffA); PG8_STAGE(PG8_SB(0, 1), cB + hstep, voffB); PG8_STAGE(PG8_SA(0, 1), cA + hstep, voffA);
        if (wr == 1) PG8_BAR;
        PG8_WAIT_V(4); PG8_BAR;
        PG8_STAGE(PG8_SB(1, 0), cB + kstep, voffB); PG8_STAGE(PG8_SA(1, 0), cA + kstep, voffA); PG8_STAGE(PG8_SB(1, 1), cB + hstep + kstep, voffB);
        PG8_WAIT_V(6); PG8_BAR;
    }
    for (;;) {
        const bool has_next = S.next(ui + 1, nxt);
        const char* nA = has_next ? (const char*)g.A + (size_t)nxt.pm * tstep : cA; const char* nB = has_next ? (const char*)g.Bt + (size_t)nxt.pn * tstep : cB;
        for (int t = 0; t < nt; t += 2) {
            const bool last = (t == nt - 2);
            const char* a1 = cA + (size_t)(t + 1) * kstep;
            const char* a2 = last ? nA : cA + (size_t)(t + 2) * kstep; const char* b2 = last ? nB : cB + (size_t)(t + 2) * kstep;
            const char* a3 = a2 + kstep; const char* b3 = b2 + kstep;
            if (last && has_next) S.a_ready(nxt);
            if constexpr (SP2) {
            PG8_LDB(B0, 0, 0); PG8_LDB(B1, 0, 1); PG8_SCHED; PG8_LDA(At, 0, 0); PG8_STAGE(PG8_SA(1, 1), a1 + hstep, voffA);
            PG8_WAIT_V(8); PG8_WAIT_L(0); PG8_BAR; PG8_MMA(0, 0, At, B0); PG8_MMA(0, 1, At, B1); PG8_BAR; PG8_SCHED;
            PG8_LDA(At, 0, 1); PG8_STAGE(PG8_SB(0, 0), b2, voffB); PG8_STAGE(PG8_SB(0, 1), b2 + hstep, voffB); PG8_STAGE(PG8_SA(0, 0), a2, voffA);
            PG8_WAIT_V(8); PG8_WAIT_L(0); PG8_BAR; PG8_MMA(1, 0, At, B0); PG8_MMA(1, 1, At, B1); PG8_BAR; PG8_SCHED;
            PG8_LDB(B0, 1, 0); PG8_LDB(B1, 1, 1); PG8_SCHED; PG8_LDA(At, 1, 0); PG8_STAGE(PG8_SA(0, 1), a2 + hstep, voffA);
            PG8_WAIT_V(8); PG8_WAIT_L(0); PG8_BAR; PG8_MMA(0, 0, At, B0); PG8_MMA(0, 1, At, B1); PG8_BAR; PG8_SCHED;
            PG8_LDA(At, 1, 1); PG8_STAGE(PG8_SB(1, 0), b3, voffB); PG8_STAGE(PG8_SB(1, 1), b3 + hstep, voffB); PG8_STAGE(PG8_SA(1, 0), a3, voffA);
            PG8_WAIT_V(8); PG8_WAIT_L(0); PG8_BAR; PG8_MMA(1, 0, At, B0); PG8_MMA(1, 1, At, B1); PG8_BAR; PG8_SCHED;
            } else {
            PG8_LDB(B0, 0, 0); PG8_SCHED; PG8_LDA(At, 0, 0); PG8_STAGE(PG8_SA(1, 1), a1 + hstep, voffA);
            PG8_WAIT_L(8); PG8_BAR; PG8_WAIT_L(0); PG8_MMA(0, 0, At, B0); PG8_BAR; PG8_SCHED;
            PG8_LDB(B1, 0, 1); PG8_STAGE(PG8_SB(0, 0), b2, voffB);
            PG8_BAR; PG8_WAIT_L(0); PG8_MMA(0, 1, At, B1); PG8_BAR;
            PG8_LDA(At, 0, 1); PG8_STAGE(PG8_SA(0, 0), a2, voffA);
            PG8_BAR; PG8_WAIT_L(0); PG8_MMA(1, 0, At, B0); PG8_BAR; PG8_SCHED;
            PG8_STAGE(PG8_SB(0, 1), b2 + hstep, voffB);
            PG8_WAIT_V(6); PG8_BAR; PG8_MMA(1, 1, At, B1); PG8_BAR;
            PG8_LDB(B0, 1, 0); PG8_SCHED; PG8_LDA(At, 1, 0); PG8_STAGE(PG8_SA(0, 1), a2 + hstep, voffA);
            PG8_WAIT_L(8); PG8_BAR; PG8_WAIT_L(0); PG8_MMA(0, 0, At, B0); PG8_BAR; PG8_SCHED;
            PG8_LDB(B1, 1, 1); PG8_STAGE(PG8_SB(1, 0), b3, voffB);
            PG8_BAR; PG8_WAIT_L(0); PG8_MMA(0, 1, At, B1); PG8_BAR;
            PG8_LDA(At, 1, 1); PG8_STAGE(PG8_SA(1, 0), a3, voffA);
            PG8_BAR; PG8_WAIT_L(0); PG8_MMA(1, 0, At, B0); PG8_BAR; PG8_SCHED;
            PG8_STAGE(PG8_SB(1, 1), b3 + hstep, voffB);
            PG8_WAIT_V(6); PG8_BAR; PG8_MMA(1, 1, At, B1); PG8_BAR;
            }
        }
        if constexpr (ALIGN_EPI) { if (wr == 0) PG8_BAR; }
        if constexpr (!Epi::AFTER_DRAIN) { E(acc, cur, wr, wc, fr, fq); S.done(cur); }
        if (!has_next) break;
#pragma unroll
        for (int a = 0; a < 2; ++a)
#pragma unroll
            for (int b = 0; b < 2; ++b)
#pragma unroll
                for (int m = 0; m < 4; ++m)
#pragma unroll
                    for (int n = 0; n < 2; ++n) acc[a][b][m][n] = (f32x4){0.f, 0.f, 0.f, 0.f};
        cur = nxt; cA = nA; cB = nB; ++ui;
        if constexpr (ALIGN_EPI) { if (wr == 1) PG8_BAR; }
    }
    PG8_WAIT_V(0);
    if constexpr (!ALIGN_EPI) { if (wr == 0) PG8_BAR; }
    PG8_BAR;
    if constexpr (Epi::AFTER_DRAIN) { E.fused(acc, cur, wr, wc, fr, fq, lds, wid, lane); S.done(cur); }
#undef PG8_SA
#undef PG8_SB
#undef PG8_STAGE
#undef PG8_LDA
#undef PG8_LDB
#undef PG8_MMA
#undef PG8_WAIT_V
#undef PG8_WAIT_L
#undef PG8_BAR
#undef PG8_SCHED
}
}

template <class F> struct EpiF4 {
    static constexpr bool PERM = false, AFTER_DRAIN = false; F f;
    __device__ __forceinline__ void operator()(const pg8::f32x4 (&acc)[2][2][4][2], const pg8::Unit& u, int wr, int wc, int fr, int fq) const {
        const int row0 = u.pm * 256 + wr * 64 + fr, col0 = u.pn * 256 + wc * 32 + 4 * fq;
#pragma unroll
        for (int ai = 0; ai < 2; ++ai)
#pragma unroll
            for (int m = 0; m < 4; ++m)
#pragma unroll
                for (int bj = 0; bj < 2; ++bj) f(row0 + ai * 128 + m * 16, col0 + bj * 128, acc[ai][bj][m][0], acc[ai][bj][m][1]);
    }
};
typedef unsigned short bf16;
__device__ __forceinline__ unsigned f2bf(float f) { unsigned u = __builtin_bit_cast(unsigned, f); return (u + 0x7fffu + ((u >> 16) & 1u)) >> 16; }
__device__ __forceinline__ unsigned pk2(float lo, float hi) { unsigned r; asm("v_cvt_pk_bf16_f32 %0, %1, %2" : "=v"(r) : "v"(lo), "v"(hi)); return r; }
__device__ __forceinline__ float bf2f(unsigned short h) { return __uint_as_float((unsigned)h << 16); }
__device__ __forceinline__ float bflo(unsigned w) { return __uint_as_float(w << 16); }
__device__ __forceinline__ float bfhi(unsigned w) { return __uint_as_float(w & 0xffff0000u); }
typedef unsigned u32x2 __attribute__((ext_vector_type(2)));
typedef unsigned u32x4 __attribute__((ext_vector_type(4)));

__device__ __forceinline__ f32x4 bf4f(u32x2 w) { return (f32x4){bflo(w.x), bfhi(w.x), bflo(w.y), bfhi(w.y)}; }
__device__ __forceinline__ void p0_transpose_item(const float* W, int K, int N, bf16* WT, float* scr, int item, int lane) {
    const int nblk = N / 32, kb = item / nblk, nb = item % nblk, k0 = 64 * kb, n0 = 32 * nb;
#pragma unroll 8
    for (int i = 0; i < 32; ++i) { const int kk = 2 * i + (lane >> 5); scr[kk * 33 + (lane & 31)] = W[(size_t)(k0 + kk) * N + n0 + (lane & 31)]; }
    asm volatile("s_waitcnt lgkmcnt(0)" ::: "memory");
    const int c = lane & 7;
#pragma unroll
    for (int j = 0; j < 4; ++j) { const int n = (lane >> 3) + 8 * j; const float* sp = scr + (8 * c) * 33 + n;
        u32x4 o; o.x = pk2(sp[0 * 33], sp[1 * 33]); o.y = pk2(sp[2 * 33], sp[3 * 33]); o.z = pk2(sp[4 * 33], sp[5 * 33]); o.w = pk2(sp[6 * 33], sp[7 * 33]);
        *(u32x4*)(WT + (size_t)(n0 + n) * K + k0 + 8 * c) = o; }
    asm volatile("s_waitcnt lgkmcnt(0)" ::: "memory");
}
__device__ __forceinline__ void phase_prologue(const Args& a, float* lds) {
    const int tid = TID, bid = BID, gdim = GDIM;
    float* MOD = (float*)(a.ws + WS_MOD);
    {
        for (int i = tid; i < 3 * D; i += NT) { const int g = i >> 10, k = i & 1023; const float c = (g == 0) ? a.in[I_CCTX][k] : a.in[I_C][(g - 1) * D + k]; lds[i] = siluf(c); }
        __syncthreads();
    }
    for (int it = bid; it < NLAYER * 192; it += gdim) {
        const int l = it / 192, cb = it % 192;
        const float* sl = lds;
        const int cl = tid & 31, ks = tid >> 5;
        float a0 = 0.f, a1 = 0.f, a2 = 0.f;
        const float* w = a.in[I_WADA] + ((size_t)l * D + ks * 64) * 6144 + cb * 32 + cl;
#pragma unroll 16
        for (int k = 0; k < 64; ++k) { const float wv = w[(size_t)k * 6144]; const int kk = ks * 64 + k; a0 += sl[kk] * wv; a1 += sl[D + kk] * wv; a2 += sl[2 * D + kk] * wv; }
        float* red = lds + 3 * D;
        red[(ks * 3 + 0) * 32 + cl] = a0; red[(ks * 3 + 1) * 32 + cl] = a1; red[(ks * 3 + 2) * 32 + cl] = a2;
        __syncthreads();
        if (tid < 96) { const int g = tid >> 5, c = tid & 31; float sm = a.in[I_BADA][l * 6144 + cb * 32 + c];
#pragma unroll
            for (int q = 0; q < 16; ++q) sm += red[(q * 3 + g) * 32 + c];
            MOD[(size_t)(l * 3 + g) * 6144 + cb * 32 + c] = sm; }
        __syncthreads();
    }
    {
        const int lane = tid & 63, gw = bid * NWAVES + (tid >> 6), ngw = gdim * NWAVES;
        float* scr = lds + (tid >> 6) * 4096;
        constexpr int I_IN = 16 * 57, I_SQ = 16 * 32, PER_L = I_IN + 2 * I_SQ;
        for (int it = gw; it < NLAYER * PER_L; it += ngw) {
            const int l = it / PER_L; int r = it % PER_L;
            if (r < I_IN) { p0_transpose_item(a.in[I_WIN] + (size_t)l * D * INW, D, INW, (bf16*)(a.ws + WS_WIN_T) + (size_t)l * 2048 * D, scr, r, lane); continue; } r -= I_IN;
            if (r < I_SQ) { p0_transpose_item(a.in[I_WOUT] + (size_t)l * D * D, D, D, (bf16*)(a.ws + WS_WOUT_T) + (size_t)l * D * D, scr, r, lane); continue; } r -= I_SQ;
            p0_transpose_item(a.in[I_WQ] + (size_t)l * D * D, D, D, (bf16*)(a.ws + WS_WQ_T) + (size_t)l * D * D, scr, r, lane);
        }
        for (int i = bid * NT + tid; i < NLAYER * 28672; i += gdim * NT) { const int l = i / 28672, r = i % 28672;
            ((u32x4*)((bf16*)(a.ws + WS_WIN_T) + ((size_t)l * 2048 + INW) * D))[r] = (u32x4){0u, 0u, 0u, 0u}; }
    }
    {
        float* rt = (float*)(a.ws + WS_ROPE);
        for (int i = bid * NT + tid; i < 64 * 16; i += gdim * NT) { float sn, cs; sincosf((float)(i >> 4) * exp2f(-(float)(i & 15) * 0.83048202372184058696f), &sn, &cs); rt[2 * i] = cs; rt[2 * i + 1] = sn; }
        const f32x4* sk = (const f32x4*)a.in[I_SUBK]; u32x2* skb = (u32x2*)(a.ws + WS_SKB);
        for (int i = bid * NT + tid; i < NLAYER * 16 * 128 * 64 / 4; i += gdim * NT) { const f32x4 v = sk[i]; skb[i] = (u32x2){pk2(v.x, v.y), pk2(v.z, v.w)}; }
    }
}

__device__ __forceinline__ void phase_cvt_tables(const Args& a, int l) {
    const int tid = TID, bid = BID, gdim = GDIM;
    {
        const int lane = tid & 63, gw = bid * NWAVES + (tid >> 6), ngw = gdim * NWAVES;
        unsigned char* u8 = a.ws + WS_U8; unsigned char* v8 = a.ws + WS_V8; float* suv = (float*)(a.ws + WS_SUV);
        for (int row = l * 16384 + gw; row < (l + 1) * 16384; row += ngw) {
#pragma unroll
            for (int tb = 0; tb < 2; ++tb) {
                const float* src = (tb ? a.in[I_PV] : a.in[I_PU]) + (size_t)row * D + 16 * lane;
                f32x4 x[4]; float am = 0.f;
#pragma unroll
                for (int q = 0; q < 4; ++q) { x[q] = *(const f32x4*)(src + 4 * q); am = fmaxf(am, fmaxf(fmaxf(fabsf(x[q].x), fabsf(x[q].y)), fmaxf(fabsf(x[q].z), fabsf(x[q].w)))); }
                am = wave_max_u(am);
                const float inv = am > 0.f ? 448.f / am : 0.f;
                u32x4 o;
#pragma unroll
                for (int q = 0; q < 4; ++q) { int p = __builtin_amdgcn_cvt_pk_fp8_f32(x[q].x * inv, x[q].y * inv, 0, false); p = __builtin_amdgcn_cvt_pk_fp8_f32(x[q].z * inv, x[q].w * inv, p, true); o[q] = (unsigned)p; }
                *(u32x4*)((tb ? v8 : u8) + (size_t)row * D + 16 * lane) = o;
                if (lane == 0) suv[(size_t)row * 2 + tb] = am * (1.f / 448.f);
            }
        }
    }
}

template <bool X16  >
__device__ __forceinline__ void phase_norm(const void* Xv, const float* X2  , const float* gain, const float* modl, int sh_off, int sc_off, bf16* H) {
    const int tid = TID, bid = BID, gdim = GDIM, lane = tid & 63, gw = bid * NWAVES + (tid >> 6), ngw = gdim * NWAVES;
    const float* X = (const float*)Xv; const bf16* Xb = (const bf16*)Xv;
    f32x4 nx[4]; u32x2 nb[4];
    { const int t = min(gw, NTOK - 1);
      if (X16) { const u32x2* xr = (const u32x2*)(Xb + (size_t)t * D) + lane;
#pragma unroll
        for (int j = 0; j < 4; ++j) nb[j] = xr[64 * j]; }
      else { const f32x4* xr = (const f32x4*)((X2 && t >= NCTX) ? X2 + (size_t)(t - NCTX) * D : X + (size_t)t * D) + lane;
#pragma unroll
        for (int j = 0; j < 4; ++j) nx[j] = xr[64 * j]; } }
    for (int t = gw; t < NTOK; t += ngw) {
        f32x4 v[4]; float ss = 0.f;
#pragma unroll
        for (int j = 0; j < 4; ++j) v[j] = X16 ? bf4f(nb[j]) : nx[j];
        { const int tn = min(t + ngw, NTOK - 1);
          if (X16) { const u32x2* xr = (const u32x2*)(Xb + (size_t)tn * D) + lane;
#pragma unroll
            for (int j = 0; j < 4; ++j) nb[j] = xr[64 * j]; }
          else { const f32x4* xr = (const f32x4*)((X2 && tn >= NCTX) ? X2 + (size_t)(tn - NCTX) * D : X + (size_t)tn * D) + lane;
#pragma unroll
            for (int j = 0; j < 4; ++j) nx[j] = xr[64 * j]; } }
#pragma unroll
        for (int j = 0; j < 4; ++j) ss += v[j].x * v[j].x + v[j].y * v[j].y + v[j].z * v[j].z + v[j].w * v[j].w;
        ss = wave_sum_u(ss);
        const float r = 1.0f / sqrtf(ss * (1.f / D) + EPS);
        const float* m = modl + grp_of(t) * 6144;
        u32x2* hr = (u32x2*)(H + (size_t)t * D) + lane;
#pragma unroll
        for (int j = 0; j < 4; ++j) { const int col = 4 * (lane + 64 * j);
            const f32x4 g = *(const f32x4*)(gain + col), sc = *(const f32x4*)(m + sc_off + col), sh = *(const f32x4*)(m + sh_off + col);
            const f32x4 o = v[j] * r * g * (sc + 1.0f) + sh;
            hr[64 * j] = (u32x2){pk2(o.x, o.y), pk2(o.z, o.w)}; }
    }
}

struct FInProj { bf16* P; float* out; int l; const float* rope;
    __device__ __forceinline__ void operator()(int row, int col, const pg8::f32x4& v0, const pg8::f32x4& v1) const {
        if (col >= INW) return;
        f32x4 a = {v0[0], v0[1], v0[2], v0[3]}, b = {v1[0], v1[1], v1[2], v1[3]};
        if (row < NCTX && col >= C_AK) { const int bt = row >> 8, tt = row & 255, c = col - C_AK;
            const size_t base = ((size_t)(bt * NLAYER + l) * 256 + tt) * 128;
            float* o = (c < 128) ? (out + OUT_CK + base + c) : (out + OUT_CV + base + c - 128);
            *(f32x4*)o = a; *(f32x4*)(o + 16) = b; }
        if (col >= C_AQ && col < C_AV) {
            if (row >= NCTX) { const int tl = (row - NCTX) & 4095, half = ((col - C_AQ) >> 5) & 1, pos = half ? (tl & 63) : (tl >> 6), f0 = col & 15;
                const float* rt = rope + (pos * 16 + f0) * 2;
                { const f32x4 t = *(const f32x4*)rt; const float x1 = a.x, x2 = b.x, y1 = a.y, y2 = b.y;
                  a.x = x1 * t.x - x2 * t.y; b.x = x1 * t.y + x2 * t.x; a.y = y1 * t.z - y2 * t.w; b.y = y1 * t.w + y2 * t.z; }
                { const f32x4 t = *(const f32x4*)(rt + 4); const float x1 = a.z, x2 = b.z, y1 = a.w, y2 = b.w;
                  a.z = x1 * t.x - x2 * t.y; b.z = x1 * t.y + x2 * t.x; a.w = y1 * t.z - y2 * t.w; b.w = y1 * t.w + y2 * t.z; } }
            if (col < C_AK) { a = a * 0.18033688011112042f; b = b * 0.18033688011112042f; } }
        bf16* p = P + (size_t)row * INW + col;
        *(u32x2*)p = (u32x2){pk2(a.x, a.y), pk2(a.z, a.w)}; *(u32x2*)(p + 16) = (u32x2){pk2(b.x, b.y), pk2(b.z, b.w)};
    } };
struct FResid { bf16* X; const float* b0; const float* b1; const bf16* xb; const float* modl; int gate_off;
    __device__ __forceinline__ void operator()(int row, int col, const pg8::f32x4& v0, const pg8::f32x4& v1) const {
        const float* g = modl + grp_of(row) * 6144 + gate_off + col; bf16* xp = X + (size_t)row * D + col;
        f32x4 ba, bb;
        if (xb) { const bf16* bp = xb + (size_t)row * D + col; ba = bf4f(*(const u32x2*)bp); bb = bf4f(*(const u32x2*)(bp + 16)); }
        else { const float* bp = (row < NCTX ? b0 + (size_t)row * D : b1 + (size_t)(row - NCTX) * D) + col; ba = *(const f32x4*)bp; bb = *(const f32x4*)(bp + 16); }
        const f32x4 ra = ba + *(const f32x4*)g * (f32x4){v0[0], v0[1], v0[2], v0[3]}, rb = bb + *(const f32x4*)(g + 16) * (f32x4){v1[0], v1[1], v1[2], v1[3]};
        *(u32x2*)xp = (u32x2){pk2(ra.x, ra.y), pk2(ra.z, ra.w)}; *(u32x2*)(xp + 16) = (u32x2){pk2(rb.x, rb.y), pk2(rb.z, rb.w)}; } };
struct FStore { bf16* Q;
    __device__ __forceinline__ void operator()(int row, int col, const pg8::f32x4& v0, const pg8::f32x4& v1) const {
        bf16* q = Q + ((size_t)(col >> 6) * NTOK + row) * 64 + (col & 63);
        *(u32x2*)q = (u32x2){pk2(v0[0], v0[1]), pk2(v0[2], v0[3])}; *(u32x2*)(q + 16) = (u32x2){pk2(v1[0], v1[1]), pk2(v1[2], v1[3])}; } };

__device__ __forceinline__ void phase_mixprep(const Args& a, int l, float* lds) {
    const int tid = TID, bid = BID, gdim = GDIM;
    const bf16* P = (const bf16*)(a.ws + WS_P); bf16* MIX = (bf16*)(a.ws + WS_MIX);
    float* XP = lds; float* DF = lds + 47 * 256;
    for (int tile = bid; tile < NTOK / 32; tile += gdim) {
        const int t0 = tile * 32;
        int s0, T; if (t0 < NCTX) { s0 = t0 & ~255; T = 256; } else { s0 = NCTX + ((t0 - NCTX) & ~4095); T = 4096; }
        { u32x2 wv[6];
#pragma unroll
          for (int it = 0; it < 6; ++it) { const int i = min(tid + it * NT, 47 * 64 - 1), rr = i >> 6, c4 = (i & 63) * 4, t = min(max(t0 - 8 + rr, s0), s0 + T - 1);
              wv[it] = *(const u32x2*)(P + (size_t)t * INW + c4); }
#pragma unroll
          for (int it = 0; it < 6; ++it) { const int i = tid + it * NT, rr = i >> 6, c4 = (i & 63) * 4, t = t0 - 8 + rr;
              if (i < 47 * 64) { const bool in = t >= s0 && t < s0 + T; const u32x2 w = wv[it];
                  *(f32x4*)&XP[rr * 256 + c4] = in ? (f32x4){bflo(w.x), bfhi(w.x), bflo(w.y), bfhi(w.y)} : (f32x4){0.f, 0.f, 0.f, 0.f}; } } }
        __syncthreads();
        if (tid < 256) { float run = 0.f;
#pragma unroll 8
            for (int rr = 0; rr < 47; ++rr) { run += XP[rr * 256 + tid]; XP[rr * 256 + tid] = run; } }
        __syncthreads();
        { const int ch = tid & 255, g = ch >> 6, win = 2 << g, left = win / 2, right = win - 1 - left;
          for (int tt = (tid >> 8) * 16; tt < (tid >> 8) * 16 + 16; ++tt) { const int tq = t0 + tt - s0;
              const int lo = max(tq - left, 0), hi = min(tq + right + 1, T), rlo = lo - tq + tt + 8, rhi = hi - tq + tt + 8;
              const float sum = XP[(rhi - 1) * 256 + ch] - (rlo > 0 ? XP[(rlo - 1) * 256 + ch] : 0.f);
              DF[tt * 256 + ch] = sum / (float)(hi - lo) - (XP[(tt + 8) * 256 + ch] - XP[(tt + 7) * 256 + ch]); } }
        __syncthreads();
        { const int tg = tid >> 6, og = tid & 63, g = og >> 4, oc = (og & 15) * 4;
          const float* w = a.in[I_POOLW] + (size_t)((l * 4 + g) * 64) * 64 + oc;
          f32x4 acc[4];
#pragma unroll
          for (int i = 0; i < 4; ++i) acc[i] = (f32x4){0.f, 0.f, 0.f, 0.f};
#pragma unroll 2
          for (int c = 0; c < 64; c += 4) {
              const f32x4 w0 = *(const f32x4*)(w + (c + 0) * 64), w1 = *(const f32x4*)(w + (c + 1) * 64), w2 = *(const f32x4*)(w + (c + 2) * 64), w3 = *(const f32x4*)(w + (c + 3) * 64);
#pragma unroll
              for (int i = 0; i < 4; ++i) { const f32x4 d = *(const f32x4*)&DF[(tg * 4 + i) * 256 + g * 64 + c]; acc[i] += w0 * d.x + w1 * d.y + w2 * d.z + w3 * d.w; } }
          const f32x4 sc = *(const f32x4*)(a.in[I_POOLS] + l * 256 + g * 64 + oc);
#pragma unroll
          for (int i = 0; i < 4; ++i) { const f32x4 y = acc[i] * sc; *(u32x2*)(MIX + (size_t)(t0 + tg * 4 + i) * D + g * 64 + oc) = (u32x2){pk2(y.x, y.y), pk2(y.z, y.w)}; } }
        __syncthreads();
    }
}

typedef short bf16x8 __attribute__((ext_vector_type(8)));
typedef float f32x16 __attribute__((ext_vector_type(16)));
__device__ __forceinline__ int at_vpos(int kk) { const int s = kk >> 4, rem = kk & 15; return 16 * s + 8 * ((rem >> 2) & 1) + (((rem >> 3) << 2) | (rem & 3)); }
__device__ __forceinline__ bf16x8 at_pack_step(const f32x16& x, int s) {
    u32x4 p;
    asm volatile("v_cvt_pk_bf16_f32 %0, %4, %5\n\tv_cvt_pk_bf16_f32 %1, %6, %7\n\tv_cvt_pk_bf16_f32 %2, %8, %9\n\tv_cvt_pk_bf16_f32 %3, %10, %11\n\ts_nop 1"
                 : "=&v"(p[0]), "=&v"(p[1]), "=&v"(p[2]), "=&v"(p[3])
                 : "v"(x[8 * s]), "v"(x[8 * s + 1]), "v"(x[8 * s + 2]), "v"(x[8 * s + 3]), "v"(x[8 * s + 4]), "v"(x[8 * s + 5]), "v"(x[8 * s + 6]), "v"(x[8 * s + 7]));
    return __builtin_bit_cast(bf16x8, p);
}
constexpr int GB_QF = 0, GB_QB = 5120, GB_KF = 10240, GB_KB = 15360, GB_VT = 20480, GB_KFT = 29696, GB_KBT = 34304, GB_SFT = 38912, GB_SBT = 44032, GB_DEC = 49152, GB_SSQ = 49408, GB_QROW = 80, GB_VROW = 144;
constexpr int GB_GROUP = 51200;
template <bool LOCAL>
__device__ __forceinline__ void gla_prep(const Args& a, int l, int cg, int h, unsigned char* lds, const unsigned char* gwl, int tg) {
    const bf16* P = (const bf16*)(a.ws + WS_P);
    const int lane = tg & 63, wg = tg >> 6;
    const bf16* pr = P + (size_t)(cg * 64 + lane) * INW;
    float zf[16], zb[16];
    { const u32x4 a0 = *(const u32x4*)(pr + C_ZF), a1 = *(const u32x4*)(pr + C_ZF + 8), b0 = *(const u32x4*)(pr + C_ZB), b1 = *(const u32x4*)(pr + C_ZB + 8);
#pragma unroll
      for (int q = 0; q < 4; ++q) { zf[2 * q] = bflo(a0[q]); zf[2 * q + 1] = bfhi(a0[q]); zf[8 + 2 * q] = bflo(a1[q]); zf[8 + 2 * q + 1] = bfhi(a1[q]);
                                    zb[2 * q] = bflo(b0[q]); zb[2 * q + 1] = bfhi(b0[q]); zb[8 + 2 * q] = bflo(b1[q]); zb[8 + 2 * q + 1] = bfhi(b1[q]); } }
    const float* gw = (const float*)gwl;
    const int spos = (lane & ~31) + at_vpos(lane & 31);
#pragma unroll 2
    for (int i = 0; i < 8; ++i) {
        const int dk = 8 * wg + i, col = h * 32 + dk;
        float lf = gw[4096 + col], lb = gw[4224 + col];
#pragma unroll
        for (int r = 0; r < 16; ++r) { lf += zf[r] * gw[r * 128 + col]; lb += zb[r] * gw[2048 + r * 128 + col]; }
        const float bf = wave_prefix_incl(log_sigmoid_fast(lf) * (1.f / 16.f), lane), bb = wave_suffix_incl(log_sigmoid_fast(lb) * (1.f / 16.f), lane);
        const float q = bf2f(pr[C_GQ + col]) * 0.17677669529663687f, k = bf2f(pr[C_GK + col]);
        const unsigned short kf = (unsigned short)f2bf(k * __expf(-bf)), kb = (unsigned short)f2bf(k * __expf(-bb));
        if (LOCAL) { *(unsigned short*)(lds + GB_KFT + dk * GB_VROW + spos * 2) = kf; *(unsigned short*)(lds + GB_KBT + dk * GB_VROW + spos * 2) = kb; }
        else { *(unsigned short*)(lds + GB_QF + lane * GB_QROW + dk * 2) = (unsigned short)f2bf(q * __expf(bf)); *(unsigned short*)(lds + GB_QB + lane * GB_QROW + dk * 2) = (unsigned short)f2bf(q * __expf(bb));
               *(unsigned short*)(lds + GB_KF + lane * GB_QROW + dk * 2) = kf; *(unsigned short*)(lds + GB_KB + lane * GB_QROW + dk * 2) = kb; }
        if (LOCAL) { if (lane == 63) ((float*)(lds + GB_DEC))[dk] = __expf(bf); if (lane == 0) ((float*)(lds + GB_DEC))[32 + dk] = __expf(bb); }
    }
#pragma unroll
    for (int it = 0; it < 2; ++it) { const int r = (tg >> 3) + 32 * it, c = (tg & 7) * 8; const u32x4 v = *(const u32x4*)(P + (size_t)(cg * 64 + r) * INW + C_GV + h * 64 + c);
      const int pos0 = (r & ~31) + at_vpos(r & 31), pos = (((pos0 >> 3) ^ (tg & 7)) << 3) | (pos0 & 7);
      unsigned short* vt = (unsigned short*)(lds + GB_VT + c * GB_VROW + pos * 2);
      vt[0 * (GB_VROW / 2)] = (unsigned short)v.x; vt[1 * (GB_VROW / 2)] = (unsigned short)(v.x >> 16); vt[2 * (GB_VROW / 2)] = (unsigned short)v.y; vt[3 * (GB_VROW / 2)] = (unsigned short)(v.y >> 16);
      vt[4 * (GB_VROW / 2)] = (unsigned short)v.z; vt[5 * (GB_VROW / 2)] = (unsigned short)(v.z >> 16); vt[6 * (GB_VROW / 2)] = (unsigned short)v.w; vt[7 * (GB_VROW / 2)] = (unsigned short)(v.w >> 16); }
}
constexpr int GB_GW = 2 * GB_GROUP;
__device__ __forceinline__ void gla_stage_gates(const Args& a, int l, unsigned char* lds0, int tid) {
    float* gw = (float*)(lds0 + GB_GW);
    const float* wf = a.in[I_GWF] + (size_t)l * 2048; const float* wb = a.in[I_GWB] + (size_t)l * 2048;
    *(f32x4*)(gw + 4 * tid) = *(const f32x4*)(wf + 4 * tid); *(f32x4*)(gw + 2048 + 4 * tid) = *(const f32x4*)(wb + 4 * tid);
    if (tid < 128) { gw[4096 + tid] = a.in[I_GBF][l * 128 + tid]; gw[4224 + tid] = a.in[I_GBB][l * 128 + tid]; }
    __syncthreads();
}
__device__ __forceinline__ void phase_gla_local(const Args& a, int l, unsigned char* lds0) {
    const int tid = TID, bid = BID, gdim = GDIM, lane = tid & 63, w = __builtin_amdgcn_readfirstlane(tid >> 6), r = lane & 31, hh = lane >> 5, grp = w >> 2, wg = w & 3, tg = tid & 255;
    unsigned char* lds = lds0 + grp * GB_GROUP;
    float* DS = (float*)(a.ws + WS_DS); float* DEC = (float*)(a.ws + WS_DEC);
    gla_stage_gates(a, l, lds0, tid);
    for (int u0 = 2 * bid; u0 < 1024; u0 += 2 * gdim) {
        const int unit = u0 + grp, cg = unit >> 2, h = unit & 3;
        gla_prep<true>(a, l, cg, h, lds, lds0 + GB_GW, tg);
        __syncthreads();
        { const int dvt = wg & 1, dir = wg >> 1;
            f32x16 acc;
#pragma unroll
            for (int i = 0; i < 16; ++i) acc[i] = 0.f;
            const unsigned char* ka = lds + (dir ? GB_KBT : GB_KFT) + r * GB_VROW + 16 * hh; const unsigned char* vb = lds + GB_VT + (32 * dvt + r) * GB_VROW; const int swv = (4 * dvt + (r >> 3)) & 7;
#pragma unroll
            for (int st = 0; st < 4; ++st) acc = __builtin_amdgcn_mfma_f32_32x32x16_bf16(*(const bf16x8*)(ka + 32 * st), *(const bf16x8*)(vb + (((2 * st + hh) ^ swv) << 4)), acc, 0, 0, 0);
            float* dst = DS + ((size_t)unit * 2 + dir) * 2048 + 32 * dvt + r;
#pragma unroll
            for (int i = 0; i < 16; ++i) { const int dk = (i & 3) + 8 * (i >> 2) + 4 * hh; dst[dk * 64] = acc[i] * ((const float*)(lds + GB_DEC))[dir * 32 + dk]; }
        }
        if (tg < 64) DEC[(size_t)unit * 64 + tg] = ((const float*)(lds + GB_DEC))[tg];
        __syncthreads();
    }
}
__device__ __forceinline__ void phase_gla_scan(const Args& a, int l) {
    const int tid = TID, bid = BID, gdim = GDIM;
    const float* DS = (const float*)(a.ws + WS_DS); const float* DEC = (const float*)(a.ws + WS_DEC); float* SST = (float*)(a.ws + WS_SST);
    for (int item = bid; item < 256; item += gdim) {
        if (tid < 128) {
            const int chain = item >> 4, e = (item & 15) * 128 + tid, dk = e >> 6;
            const int seq = 32 + (chain >> 3), h = (chain >> 1) & 3, dir = chain & 1, cg0 = 128 + (seq - 32) * 64;
            float S = a.in[dir ? I_SB : I_SF][(size_t)(((seq - 32) * NLAYER + l) * 4 + h) * 2048 + e];
#pragma unroll 1
            for (int i0 = 0; i0 < 64; i0 += 16) {
                float dc[16], ds[16];
#pragma unroll
                for (int j = 0; j < 16; ++j) { const int c = dir ? 63 - (i0 + j) : i0 + j; const size_t u2 = (size_t)((cg0 + c) * 4 + h) * 2 + dir; dc[j] = DEC[u2 * 32 + dk]; ds[j] = DS[u2 * 2048 + e]; }
#pragma unroll
                for (int j = 0; j < 16; ++j) { const int c = dir ? 63 - (i0 + j) : i0 + j; const size_t u2 = (size_t)((cg0 + c) * 4 + h) * 2 + dir; SST[u2 * 2048 + e] = S; S = dc[j] * S + ds[j]; }
            }
        }
    }
    for (int item = bid; item < 256 * 4; item += gdim) {
        const int chain = item >> 2, e = (item & 3) * 512 + tid, dk = e >> 6;
        const int seq = chain >> 3, h = (chain >> 1) & 3, dir = chain & 1, cg0 = seq * 4;
        float S = 0.f; float dc[4], ds[4]; size_t u2[4];
#pragma unroll
        for (int j = 0; j < 4; ++j) { const int c = dir ? 3 - j : j; u2[j] = (size_t)((cg0 + c) * 4 + h) * 2 + dir; dc[j] = DEC[u2[j] * 32 + dk]; ds[j] = DS[u2[j] * 2048 + e]; }
#pragma unroll
        for (int j = 0; j < 4; ++j) { SST[u2[j] * 2048 + e] = S; S = dc[j] * S + ds[j]; }
        a.out[(dir ? OUT_SB : OUT_SF) + (size_t)((seq * NLAYER + l) * 4 + h) * 2048 + e] = S;
    }
}
__device__ __forceinline__ void phase_gla_out(const Args& a, int l, unsigned char* lds0) {
    const int tid = TID, bid = BID, gdim = GDIM, lane = tid & 63, w = __builtin_amdgcn_readfirstlane(tid >> 6), r = lane & 31, hh = lane >> 5, grp = w >> 2, wg = w & 3, tg = tid & 255;
    unsigned char* lds = lds0 + grp * GB_GROUP;
    const bf16* P = (const bf16*)(a.ws + WS_P); const float* SST = (const float*)(a.ws + WS_SST); bf16* MIX = (bf16*)(a.ws + WS_MIX);
    gla_stage_gates(a, l, lds0, tid);
    for (int u0 = 2 * bid; u0 < 1024; u0 += 2 * gdim) {
        const int unit = u0 + grp, cg = unit >> 2, h = unit & 3;
        gla_prep<false>(a, l, cg, h, lds, lds0 + GB_GW, tg);
#pragma unroll
        for (int it = 0; it < 2; ++it) { const int rr = (tg >> 3) + 32 * it, c = (tg & 7) * 8, dir = rr >> 5, dk = rr & 31; const float* sp = SST + (size_t)unit * 4096 + rr * 64 + c;
          const f32x4 s0 = *(const f32x4*)sp, s1 = *(const f32x4*)(sp + 4);
          unsigned short* st = (unsigned short*)(lds + (dir ? GB_SBT : GB_SFT) + c * GB_QROW + ((((dk >> 3) ^ (tg & 3)) << 3) | (dk & 7)) * 2);
          st[0 * (GB_QROW / 2)] = (unsigned short)f2bf(s0.x); st[1 * (GB_QROW / 2)] = (unsigned short)f2bf(s0.y); st[2 * (GB_QROW / 2)] = (unsigned short)f2bf(s0.z); st[3 * (GB_QROW / 2)] = (unsigned short)f2bf(s0.w);
          st[4 * (GB_QROW / 2)] = (unsigned short)f2bf(s1.x); st[5 * (GB_QROW / 2)] = (unsigned short)f2bf(s1.y); st[6 * (GB_QROW / 2)] = (unsigned short)f2bf(s1.z); st[7 * (GB_QROW / 2)] = (unsigned short)f2bf(s1.w); }
        __syncthreads();
        const int tt = wg & 1, dvt = wg >> 1, tq = 32 * tt + r;
        f32x16 o;
#pragma unroll
        for (int i = 0; i < 16; ++i) o[i] = 0.f;
        {
            bf16x8 qF[2], qB[2];
#pragma unroll
            for (int st = 0; st < 2; ++st) { qF[st] = *(const bf16x8*)(lds + GB_QF + tq * GB_QROW + 32 * st + 16 * hh); qB[st] = *(const bf16x8*)(lds + GB_QB + tq * GB_QROW + 32 * st + 16 * hh); }
#pragma unroll
            for (int ts = 0; ts < 2; ++ts) {
                f32x16 af, ab;
#pragma unroll
                for (int i = 0; i < 16; ++i) { af[i] = 0.f; ab[i] = 0.f; }
#pragma unroll
                for (int st = 0; st < 2; ++st) {
                    af = __builtin_amdgcn_mfma_f32_32x32x16_bf16(*(const bf16x8*)(lds + GB_KF + (32 * ts + r) * GB_QROW + 32 * st + 16 * hh), qF[st], af, 0, 0, 0);
                    ab = __builtin_amdgcn_mfma_f32_32x32x16_bf16(*(const bf16x8*)(lds + GB_KB + (32 * ts + r) * GB_QROW + 32 * st + 16 * hh), qB[st], ab, 0, 0, 0); }
#pragma unroll
                for (int i = 0; i < 16; ++i) { const int sidx = 32 * ts + (i & 3) + 8 * (i >> 2) + 4 * hh; af[i] = (sidx <= tq ? af[i] : 0.f) + (sidx >= tq ? ab[i] : 0.f); }
#pragma unroll
                for (int s2 = 0; s2 < 2; ++s2) { const bf16x8 pf = at_pack_step(af, s2);
                    o = __builtin_amdgcn_mfma_f32_32x32x16_bf16(*(const bf16x8*)(lds + GB_VT + (32 * dvt + r) * GB_VROW + (((4 * ts + 2 * s2 + hh) ^ ((4 * dvt + (r >> 3)) & 7)) << 4)), pf, o, 0, 0, 0); }
            }
#pragma unroll
            for (int st = 0; st < 2; ++st) {
                const int qs = ((2 * st + hh) ^ ((r >> 3) & 3)) << 4;
                o = __builtin_amdgcn_mfma_f32_32x32x16_bf16(*(const bf16x8*)(lds + GB_SFT + (32 * dvt + r) * GB_QROW + qs), qF[st], o, 0, 0, 0);
                o = __builtin_amdgcn_mfma_f32_32x32x16_bf16(*(const bf16x8*)(lds + GB_SBT + (32 * dvt + r) * GB_QROW + qs), qB[st], o, 0, 0, 0); }
            float ss = 0.f;
#pragma unroll
            for (int i = 0; i < 16; ++i) ss += o[i] * o[i];
            ss += __shfl_xor(ss, 32);
            if (hh == 0) ((float*)(lds + GB_SSQ))[dvt * 64 + tq] = ss;
        }
        __syncthreads();
        {
            const float tot = ((const float*)(lds + GB_SSQ))[tq] + ((const float*)(lds + GB_SSQ))[64 + tq];
            const float rs = 1.0f / sqrtf(tot * (1.f / 64.f) + EPS);
            const int t = cg * 64 + tq, dv0 = 32 * dvt + 4 * hh;
            const float* gn = a.in[I_GNORM] + l * 256 + h * 64 + dv0; const bf16* gp = P + (size_t)t * INW + C_GG + h * 64 + dv0; bf16* op = MIX + (size_t)t * D + 256 + h * 64 + dv0;
#pragma unroll
            for (int g = 0; g < 4; ++g) { const u32x2 gw = *(const u32x2*)(gp + 8 * g); const f32x4 gnv = *(const f32x4*)(gn + 8 * g);
                const float y0 = o[4 * g] * rs * gnv.x * siluf(bflo(gw.x)), y1 = o[4 * g + 1] * rs * gnv.y * siluf(bfhi(gw.x)), y2 = o[4 * g + 2] * rs * gnv.z * siluf(bflo(gw.y)), y3 = o[4 * g + 3] * rs * gnv.w * siluf(bfhi(gw.y));
                *(u32x2*)(op + 8 * g) = (u32x2){pk2(y0, y1), pk2(y2, y3)}; }
        }
        __syncthreads();
    }
}

constexpr int AT_KROW = 144, AT_MAXK = 320, AT_VT = AT_MAXK * AT_KROW, AT_VROW = AT_MAXK * 2 + 16;
__device__ __forceinline__ void at_stage(unsigned char* lds, const float* kp, int kstride, const float* vp, int vstride, int nkeys, int tid) {
    f32x4 kk[4][2], vv[4][2];
#pragma unroll
    for (int it = 0; it < 4; ++it) { const int idx = min(tid + it * NT, nkeys * 8 - 1), key = idx >> 3, d8 = (idx & 7) * 8;
        kk[it][0] = *(const f32x4*)(kp + (size_t)key * kstride + d8); kk[it][1] = *(const f32x4*)(kp + (size_t)key * kstride + d8 + 4);
        vv[it][0] = *(const f32x4*)(vp + (size_t)key * vstride + d8); vv[it][1] = *(const f32x4*)(vp + (size_t)key * vstride + d8 + 4); }
#pragma unroll
    for (int it = 0; it < 4; ++it) { const int idx = tid + it * NT, key = idx >> 3, d8 = (idx & 7) * 8;
        if (idx < nkeys * 8) {
            const f32x4 k0 = kk[it][0], k1 = kk[it][1], v0 = vv[it][0], v1 = vv[it][1];
            *(u32x4*)(lds + key * AT_KROW + d8 * 2) = (u32x4){pk2(k0.x, k0.y), pk2(k0.z, k0.w), pk2(k1.x, k1.y), pk2(k1.z, k1.w)};
            const int pos0 = (key & ~31) + at_vpos(key & 31), pos = (((pos0 >> 3) ^ (idx & 7)) << 3) | (pos0 & 7);
            unsigned short* vt = (unsigned short*)(lds + AT_VT + d8 * AT_VROW + pos * 2);
            vt[0 * (AT_VROW / 2)] = (unsigned short)f2bf(v0.x); vt[1 * (AT_VROW / 2)] = (unsigned short)f2bf(v0.y); vt[2 * (AT_VROW / 2)] = (unsigned short)f2bf(v0.z); vt[3 * (AT_VROW / 2)] = (unsigned short)f2bf(v0.w);
            vt[4 * (AT_VROW / 2)] = (unsigned short)f2bf(v1.x); vt[5 * (AT_VROW / 2)] = (unsigned short)f2bf(v1.y); vt[6 * (AT_VROW / 2)] = (unsigned short)f2bf(v1.z); vt[7 * (AT_VROW / 2)] = (unsigned short)f2bf(v1.w); } }
}
__device__ __forceinline__ void at_stage16(unsigned char* lds, const bf16* kp, const bf16* vp, int stride, int nkeys, int tid) {
    u32x4 kk[5], vv[5];
#pragma unroll
    for (int it = 0; it < 5; ++it) { const int idx = min(tid + it * NT, nkeys * 8 - 1), key = idx >> 3, d8 = (idx & 7) * 8;
        kk[it] = *(const u32x4*)(kp + (size_t)key * stride + d8); vv[it] = *(const u32x4*)(vp + (size_t)key * stride + d8); }
#pragma unroll
    for (int it = 0; it < 5; ++it) { const int idx = tid + it * NT, key = idx >> 3, d8 = (idx & 7) * 8;
        if (idx < nkeys * 8) {
            *(u32x4*)(lds + key * AT_KROW + d8 * 2) = kk[it];
            const u32x4 v = vv[it];
            const int pos0 = (key & ~31) + at_vpos(key & 31), pos = (((pos0 >> 3) ^ (idx & 7)) << 3) | (pos0 & 7);
            unsigned short* vt = (unsigned short*)(lds + AT_VT + d8 * AT_VROW + pos * 2);
            vt[0 * (AT_VROW / 2)] = (unsigned short)v.x; vt[1 * (AT_VROW / 2)] = (unsigned short)(v.x >> 16); vt[2 * (AT_VROW / 2)] = (unsigned short)v.y; vt[3 * (AT_VROW / 2)] = (unsigned short)(v.y >> 16);
            vt[4 * (AT_VROW / 2)] = (unsigned short)v.z; vt[5 * (AT_VROW / 2)] = (unsigned short)(v.z >> 16); vt[6 * (AT_VROW / 2)] = (unsigned short)v.w; vt[7 * (AT_VROW / 2)] = (unsigned short)(v.w >> 16); } }
}
__device__ __forceinline__ float xhalf_max(float x) { const auto r = __builtin_amdgcn_permlane32_swap(__builtin_bit_cast(unsigned, x), __builtin_bit_cast(unsigned, x), false, false);
    return fmaxf(__builtin_bit_cast(float, r[0]), __builtin_bit_cast(float, r[1])); }
__device__ __forceinline__ float xhalf_sum(float x) { const auto r = __builtin_amdgcn_permlane32_swap(__builtin_bit_cast(unsigned, x), __builtin_bit_cast(unsigned, x), false, false);
    return __builtin_bit_cast(float, r[0]) + __builtin_bit_cast(float, r[1]); }
__device__ __forceinline__ f32x16 at_scores(const unsigned char* lds, int tile, const bf16x8 (&qf)[4], int r, int h) {
    f32x16 sacc;
#pragma unroll
    for (int i = 0; i < 16; ++i) sacc[i] = 0.f;
    const unsigned char* kr = lds + (tile * 32 + r) * AT_KROW + 16 * h;
#pragma unroll
    for (int st = 0; st < 4; ++st) { const bf16x8 kf = *(const bf16x8*)(kr + 32 * st); sacc = __builtin_amdgcn_mfma_f32_32x32x16_bf16(kf, qf[st], sacc, 0, 0, 0); }
    return sacc;
}
template <bool MASKED>
__device__ __forceinline__ void at_tiles(const unsigned char* lds, int ntiles, const bf16x8 (&qf)[4], f32x16& o0, f32x16& o1, float& m, float& lsum, int r, int h, int qpos, int kpos0, int qlo, int qhi) {
    f32x16 snext = at_scores(lds, 0, qf, r, h);
    for (int tile = 0; tile < ntiles; ++tile) {
        f32x16 sacc = snext;
        if (tile + 1 < ntiles) snext = at_scores(lds, tile + 1, qf, r, h);
        if (MASKED) { const int k0 = kpos0 + tile * 32;
            if (k0 < qhi - 128 || k0 + 31 > qlo + 128) {
#pragma unroll
                for (int i = 0; i < 16; ++i) { const int dlt = qpos - (k0 + (i & 3) + 8 * (i >> 2) + 4 * h); if ((unsigned)(dlt + 128) > 256u) sacc[i] = -1.0e30f; } } }
        float mt = sacc[0];
#pragma unroll
        for (int i = 1; i < 16; ++i) mt = fmaxf(mt, sacc[i]);
        mt = fmaxf(mt, __shfl_xor(mt, 32));
        const float mn = fmaxf(m, mt), alpha = __builtin_amdgcn_exp2f(m - mn);
        float rs = 0.f;
#pragma unroll
        for (int i = 0; i < 16; ++i) { sacc[i] = __builtin_amdgcn_exp2f(sacc[i] - mn); rs += sacc[i]; }
        rs += __shfl_xor(rs, 32);
        lsum = lsum * alpha + rs; m = mn;
#pragma unroll
        for (int i = 0; i < 16; ++i) { o0[i] *= alpha; o1[i] *= alpha; }
        const unsigned char* vr = lds + AT_VT + r * AT_VROW; const int sw0 = (r >> 3) & 7, sw1 = (4 + (r >> 3)) & 7;
#pragma unroll
        for (int s2 = 0; s2 < 2; ++s2) { const bf16x8 pf = at_pack_step(sacc, s2); const int q = tile * 4 + 2 * s2 + h;
            const bf16x8 v0 = *(const bf16x8*)(vr + ((q ^ sw0) << 4)), v1 = *(const bf16x8*)(vr + 32 * AT_VROW + ((q ^ sw1) << 4));
            o0 = __builtin_amdgcn_mfma_f32_32x32x16_bf16(v0, pf, o0, 0, 0, 0); o1 = __builtin_amdgcn_mfma_f32_32x32x16_bf16(v1, pf, o1, 0, 0, 0); }
    }
}
__device__ __forceinline__ void phase_attn(const Args& a, int l, unsigned char* lds) {
    const int tid = TID, bid = BID, gdim = GDIM, lane = tid & 63, w = tid >> 6, r = lane & 31, h = lane >> 5;
    const bf16* P = (const bf16*)(a.ws + WS_P); bf16* MIX = (bf16*)(a.ws + WS_MIX);
    constexpr float LOG2E = 1.4426950408889634f;
    for (int unit = bid; unit < 512; unit += gdim) {
        const int tb = unit >> 1, kv = unit & 1, t0 = tb * 64, hq = kv * 4 + (w >> 1), tq = t0 + 32 * (w & 1) + r;
        const bool lat = t0 >= NCTX;
        bf16x8 qf[4];
        { const bf16* qp = P + (size_t)tq * INW + C_AQ + hq * 64 + 8 * h;
#pragma unroll
          for (int st = 0; st < 4; ++st) qf[st] = *(const bf16x8*)(qp + 16 * st); }
        const int tl = (tq - NCTX) & 4095;
        f32x16 o0, o1;
#pragma unroll
        for (int i = 0; i < 16; ++i) { o0[i] = 0.f; o1[i] = 0.f; }
        float m = a.in[I_SINK][l * 8 + hq] * LOG2E, lsum = 1.f;
        if (!lat) {
            const int s0 = t0 & ~255;
            at_stage16(lds, P + (size_t)s0 * INW + C_AK + kv * 64, P + (size_t)s0 * INW + C_AV + kv * 64, INW, 256, tid);
            __syncthreads();
            at_tiles<false>(lds, 8, qf, o0, o1, m, lsum, r, h, 0, 0, 0, 0);
            __syncthreads();
        } else {
            const int b = (t0 - NCTX) >> 12, tl0 = (t0 - NCTX) & 4095, lo = max(tl0 - 128, 0), hi = min(tl0 + 64 + 128, 4096);
            at_stage16(lds, P + (size_t)(NCTX + b * 4096 + lo) * INW + C_AK + kv * 64, P + (size_t)(NCTX + b * 4096 + lo) * INW + C_AV + kv * 64, INW, hi - lo, tid);
            __syncthreads();
            at_tiles<true>(lds, (hi - lo) >> 5, qf, o0, o1, m, lsum, r, h, tl, lo, tl0 + 32 * (w & 1), tl0 + 32 * (w & 1) + 31);
            __syncthreads();
            const size_t cb = (size_t)(b * NLAYER + l) * 256 * 128 + kv * 64;
            at_stage(lds, a.in[I_CK] + cb, 128, a.in[I_CV] + cb, 128, 256, tid);
            __syncthreads();
            at_tiles<false>(lds, 8, qf, o0, o1, m, lsum, r, h, 0, 0, 0, 0);
            __syncthreads();
        }
        const float inv = 1.f / lsum;
        bf16* op = MIX + (size_t)tq * D + 512 + hq * 64 + 4 * h;
#pragma unroll
        for (int g = 0; g < 4; ++g) {
            *(u32x2*)(op + 8 * g) = (u32x2){pk2(o0[4 * g] * inv, o0[4 * g + 1] * inv), pk2(o0[4 * g + 2] * inv, o0[4 * g + 3] * inv)};
            *(u32x2*)(op + 32 + 8 * g) = (u32x2){pk2(o1[4 * g] * inv, o1[4 * g + 1] * inv), pk2(o1[4 * g + 2] * inv, o1[4 * g + 3] * inv)}; }
    }
}

template <int N> __device__ __forceinline__ void bitonic_sort_desc(float (&v)[N]) {
#pragma unroll
    for (int k = 2; k <= N; k <<= 1)
#pragma unroll
        for (int j = k >> 1; j > 0; j >>= 1)
#pragma unroll
            for (int i = 0; i < N; ++i) { const int p = i ^ j; if (p > i) { const bool up = ((i & k) == 0) || (k == N);
                const float a = v[i], b = v[p], hi = __builtin_fmaxf(a, b), lo = __builtin_fminf(a, b); v[i] = up ? hi : lo; v[p] = up ? lo : hi; } }
}
__device__ __forceinline__ void merge_top16(float (&a)[16], const float (&b)[16]) {
#pragma unroll
    for (int i = 0; i < 16; ++i) a[i] = __builtin_fmaxf(a[i], b[15 - i]);
#pragma unroll
    for (int j = 8; j > 0; j >>= 1)
#pragma unroll
        for (int i = 0; i < 16; ++i) { const int p = i ^ j; if (p > i) { const float x = a[i], y = a[p]; a[i] = __builtin_fmaxf(x, y); a[p] = __builtin_fminf(x, y); } }
}
__device__ __forceinline__ void topk_list(const bf16* sk  , const bf16* qp, int hh, float (&top)[16]) {
    bf16x8 qf[4];
#pragma unroll
    for (int st = 0; st < 4; ++st) qf[st] = *(const bf16x8*)(qp + 16 * st);
#pragma unroll
    for (int kt = 0; kt < 4; ++kt) {
        bf16x8 skf[4];
#pragma unroll
        for (int st = 0; st < 4; ++st) skf[st] = *(const bf16x8*)(sk + (size_t)(32 * kt) * 64 + 16 * st);
        f32x16 acc;
#pragma unroll
        for (int i = 0; i < 16; ++i) acc[i] = 0.f;
#pragma unroll
        for (int st = 0; st < 4; ++st) acc = __builtin_amdgcn_mfma_f32_32x32x16_bf16(skf[st], qf[st], acc, 0, 0, 0);
        float v[16];
#pragma unroll
        for (int i = 0; i < 16; ++i) v[i] = __uint_as_float((__float_as_uint(acc[i]) & ~127u) | (unsigned)(32 * kt + (i & 3) + 8 * (i >> 2)) | (unsigned)(4 * hh));
        bitonic_sort_desc<16>(v);
        if (kt == 0) {
#pragma unroll
            for (int i = 0; i < 16; ++i) top[i] = v[i];
        } else merge_top16(top, v);
    }
    float oth[16];
#pragma unroll
    for (int i = 0; i < 16; ++i) oth[i] = __shfl_xor(top[i], 32);
    merge_top16(top, oth);
}
__device__ __forceinline__ void topk_pass(const Args& a, int l, float* lds, int pass) {
    const int tid = TID, lane = tid & 63, w = __builtin_amdgcn_readfirstlane(tid >> 6), r = lane & 31, hh = lane >> 5;
    const bf16* Qb = (const bf16*)(a.ws + WS_Q); int* EXP = (int*)(a.ws + WS_EXP); float* GATE = (float*)(a.ws + WS_GATE);
    {
        const int h = w, tbase = pass * 64;
#pragma unroll 1
        for (int tt = 0; tt < 2; ++tt) {
            float top[1][2][16];
#pragma unroll
            for (int p = 0; p < 2; ++p) {
                topk_list((const bf16*)(a.ws + WS_SKB) + (size_t)(l * 16 + 2 * h + p) * 128 * 64 + (size_t)r * 64 + 8 * hh, Qb + ((size_t)(2 * h + p) * NTOK + tbase + 32 * tt + r) * 64 + 8 * hh, hh, top[0][p]);
            }
            const int lane2 = lv(tid) & 63, r2 = lane2 & 31;
            const int t = tbase + 32 * tt + r2;
            float* tab = lds + w * 1024 + r2 * 32;
            if (hh == 0) {
#pragma unroll
                for (int i = 0; i < 16; i += 4) { *(f32x4*)(tab + i) = (f32x4){top[0][0][i], top[0][0][i + 1], top[0][0][i + 2], top[0][0][i + 3]};
                                                   *(f32x4*)(tab + 16 + i) = (f32x4){top[0][1][i], top[0][1][i + 1], top[0][1][i + 2], top[0][1][i + 3]}; } }
            float va[16], vb[16];
#pragma unroll
            for (int i = 0; i < 16; ++i) { va[i] = __uint_as_float(__float_as_uint(top[0][0][i]) & ~127u); vb[i] = __uint_as_float(__float_as_uint(top[0][1][i]) & ~127u); }
            float t2[16];
#pragma unroll
            for (int i = 0; i < 16; ++i) t2[i] = -3.0e38f;
#pragma unroll
            for (int i = 0; i < 16; ++i)
#pragma unroll
                for (int j = 0; j < 16 / (i + 1); ++j) {
                    float x = __uint_as_float((__float_as_uint(va[i] + vb[j]) & ~255u) | (unsigned)(i * 16 + j));
#pragma unroll
                    for (int k = 0; k < 16; ++k) { const float hi = __builtin_fmaxf(t2[k], x); x = __builtin_fminf(t2[k], x); t2[k] = hi; }
                }
            float e[16], sum = 0.f; const float m = __uint_as_float(__float_as_uint(t2[0]) & ~255u);
#pragma unroll
            for (int k = 0; k < 16; ++k) { e[k] = expf(__uint_as_float(__float_as_uint(t2[k]) & ~255u) - m); sum += e[k]; }
            const float inv = 1.f / sum;
            asm volatile("s_waitcnt lgkmcnt(0)" ::: "memory");
            if (hh == 0) {
#pragma unroll
                for (int k = 0; k < 16; k += 4) { int ex[4]; float gv[4];
#pragma unroll
                    for (int q = 0; q < 4; ++q) { const unsigned pos = __float_as_uint(t2[k + q]) & 255u;
                        const unsigned ei = __float_as_uint(tab[pos >> 4]) & 127u, ej = __float_as_uint(tab[16 + (pos & 15u)]) & 127u; ex[q] = (int)(ei * 128u + ej); gv[q] = e[k + q] * inv; }
                    *(int4*)(EXP + (size_t)t * 128 + h * 16 + k) = make_int4(ex[0], ex[1], ex[2], ex[3]);
                    *(f32x4*)(GATE + (size_t)t * 128 + h * 16 + k) = (f32x4){gv[0], gv[1], gv[2], gv[3]}; } }
            asm volatile("s_waitcnt lgkmcnt(0)" ::: "memory");
        }
    }
}
typedef float f32x2 __attribute__((ext_vector_type(2)));
typedef long i64_t;
constexpr int NTK = 8, PS_TOK = 1536, PS_WAVE = NTK * PS_TOK + 2048 + 64;
static_assert(PS_WAVE * NWAVES <= 131072, "PEER scratch");
__device__ __forceinline__ i64_t lo64(u32x4 v) { return (i64_t)(((unsigned long long)v.y << 32) | (unsigned long long)v.x); }
__device__ __forceinline__ i64_t hi64(u32x4 v) { return (i64_t)(((unsigned long long)v.w << 32) | (unsigned long long)v.z); }
#define MFMA8(A_, B_, C_) __builtin_amdgcn_mfma_f32_16x16x32_fp8_fp8((A_), (B_), (C_), 0, 0, 0)
__device__ __forceinline__ void phase_peer(const Args& a, int l, unsigned char* lds) {
    const int tid = TID, bid = BID, gdim = GDIM, lane = tid & 63, w = __builtin_amdgcn_readfirstlane(tid >> 6);
    bf16* H = (bf16*)(a.ws + WS_H); bf16* X = (bf16*)(a.ws + WS_X);
    const int* EXP = (const int*)(a.ws + WS_EXP); const float* GATE = (const float*)(a.ws + WS_GATE);
    const float* MOD = (const float*)(a.ws + WS_MOD);
    const unsigned char* U8 = a.ws + WS_U8 + (size_t)l * 16384 * D; const unsigned char* V8 = a.ws + WS_V8 + (size_t)l * 16384 * D;
    const float* SUV = (const float*)(a.ws + WS_SUV) + (size_t)l * 16384 * 2;
    unsigned char* wl = lds + w * PS_WAVE;
    const int n16 = lane & 15, rg = lane >> 4;
    int npass = 0;
    for (int pass = bid; pass < NTOK / (NWAVES * NTK); pass += gdim, ++npass) {
        const int tb = pass * (NWAVES * NTK) + NTK * w;
        const int dirn = npass & 1;
        __syncthreads(); topk_pass(a, l, (float*)lds, pass); __syncthreads();
        {
            i64_t hq[NTK][2]; float invs[NTK];
            const unsigned lane16 = 16u * (unsigned)lane; const bool odd0 = (lane & 1) != 0, odd1 = (lane & 2) != 0;
            const bool dsel1 = (n16 & 1) != 0, dsel2 = (n16 & 2) != 0, ddiag = rg == (n16 >> 2);
            unsigned char* const dummy_ = wl + NTK * PS_TOK + 4 * lane;
            { const int lane = lv(tid) & 63;
#pragma unroll
            for (int j = 0; j < NTK; ++j) {
                const int t = tb + j;
                { const u32x4 h0 = *(const u32x4*)(H + (size_t)t * D + 16 * lane), h1 = *(const u32x4*)(H + (size_t)t * D + 16 * lane + 8);
                  float hf[16];
#pragma unroll
                  for (int q = 0; q < 4; ++q) { hf[2 * q] = bflo(h0[q]); hf[2 * q + 1] = bfhi(h0[q]); hf[8 + 2 * q] = bflo(h1[q]); hf[8 + 2 * q + 1] = bfhi(h1[q]); }
                  float m = 0.f;
#pragma unroll
                  for (int q = 0; q < 16; ++q) m = fmaxf(m, fabsf(hf[q]));
                  m = fmaxf(wave_max_u(m), 1e-20f);
                  const float S = 240.f / m; invs[j] = m * (1.f / 240.f);
                  unsigned ph[4];
#pragma unroll
                  for (int q = 0; q < 4; ++q) { int pk = __builtin_amdgcn_cvt_pk_fp8_f32(hf[4 * q] * S, hf[4 * q + 1] * S, 0, false); pk = __builtin_amdgcn_cvt_pk_fp8_f32(hf[4 * q + 2] * S, hf[4 * q + 3] * S, pk, true); ph[q] = (unsigned)pk; }
                  hq[j][0] = lo64((u32x4){ph[0], ph[1], ph[2], ph[3]}); hq[j][1] = hi64((u32x4){ph[0], ph[1], ph[2], ph[3]}); }
                const int e0 = EXP[(size_t)t * 128 + lane], e1 = EXP[(size_t)t * 128 + 64 + lane];
                const float g0 = GATE[(size_t)t * 128 + lane], g1 = GATE[(size_t)t * 128 + 64 + lane];
                unsigned* SL = (unsigned*)(wl + j * PS_TOK); float* SG = (float*)(wl + j * PS_TOK + 512); float* SU = (float*)(wl + j * PS_TOK + 1024);
                volatile unsigned* CNT = (volatile unsigned*)(wl + NTK * PS_TOK);
#pragma unroll
                for (int q = 0; q < 8; ++q) CNT[lane + 64 * q] = 0u;
                const unsigned r0 = __hip_atomic_fetch_add((unsigned*)&CNT[e0 >> 5], 1u, __ATOMIC_RELAXED, __HIP_MEMORY_SCOPE_WORKGROUP);
                const unsigned r1 = __hip_atomic_fetch_add((unsigned*)&CNT[e1 >> 5], 1u, __ATOMIC_RELAXED, __HIP_MEMORY_SCOPE_WORKGROUP);
                asm volatile("s_waitcnt lgkmcnt(0)" ::: "memory");
                { unsigned c[8], run = 0u;
#pragma unroll
                  for (int q = 0; q < 8; ++q) { c[q] = CNT[8 * lane + q]; run += c[q]; }
                  const float incl = wave_prefix_incl((float)run, lane); unsigned bb = (unsigned)incl - run;
#pragma unroll
                  for (int q = 0; q < 8; ++q) { CNT[8 * lane + q] = bb; bb += c[q]; } }
                asm volatile("s_waitcnt lgkmcnt(0)" ::: "memory");
                const int pos0 = (int)(CNT[e0 >> 5] + r0), pos1 = (int)(CNT[e1 >> 5] + r1);
                asm volatile("s_waitcnt lgkmcnt(0)" ::: "memory");
                { const f32x2 sc0 = *(const f32x2*)(SUV + (size_t)e0 * 2), sc1 = *(const f32x2*)(SUV + (size_t)e1 * 2);
                  SL[pos0] = (unsigned)e0; SG[pos0] = g0 * sc0.y; SU[pos0] = sc0.x; SL[pos1] = (unsigned)e1; SG[pos1] = g1 * sc1.y; SU[pos1] = sc1.x; }
            }
            }
            asm volatile("s_waitcnt lgkmcnt(0)" ::: "memory");
#define PU_IDS(R, jj, bb) do { R##n = *(const u32x4*)(wl + (jj) * PS_TOK + 16 * (bb)); } while (0)
#define PU_LOAD(R, jj, bb) do { R##b = (bb); \
                R##s = *(const float*)(wl + (jj) * PS_TOK + 1024 + 16 * (bb) + 4 * (lane & 3)); \
                _Pragma("unroll") for (int i = 0; i < 4; ++i) { const unsigned e_ = (unsigned)__builtin_amdgcn_readfirstlane((int)R##n[i]); R##u[i] = *(const u32x4*)(U8 + (size_t)e_ * D + lane16); } } while (0)
#define PU_COMP(R, jj) do { float dd_[4]; \
                _Pragma("unroll") for (int i = 0; i < 4; ++i) { f32x4 d_ = {0.f, 0.f, 0.f, 0.f}; const i64_t al_ = lo64(R##u[i]), ah_ = hi64(R##u[i]); \
                    d_ = MFMA8(al_, hq[jj][0], d_); d_ = MFMA8(ah_, hq[jj][1], d_); \
                    const float s01_ = dsel1 ? d_[1] : d_[0], s23_ = dsel1 ? d_[3] : d_[2]; const float s_ = dsel2 ? s23_ : s01_; dd_[i] = ddiag ? s_ : 0.f; } \
                const float a01_ = odd0 ? dd_[1] : dd_[0], b01_ = odd0 ? dd_[0] : dd_[1], a23_ = odd0 ? dd_[3] : dd_[2], b23_ = odd0 ? dd_[2] : dd_[3]; \
                const float x01_ = a01_ + dpp_mov<0xB1>(b01_), x23_ = a23_ + dpp_mov<0xB1>(b23_); \
                float x_ = (odd1 ? x23_ : x01_) + dpp_mov<0x4E>(odd1 ? x01_ : x23_); \
                x_ += dpp_mov<0x124>(x_); x_ += dpp_mov<0x128>(x_); \
                const f32x4 t4_ = __builtin_amdgcn_mfma_f32_16x16x4f32(x_, 1.0f, (f32x4){0.f, 0.f, 0.f, 0.f}, 0, 0, 0); \
                const float xt_ = odd1 ? (odd0 ? t4_[3] : t4_[2]) : (odd0 ? t4_[1] : t4_[0]); \
                *(float*)(lane < 4 ? wl + (jj) * PS_TOK + 1024 + 16 * R##b + 4 * lane : dummy_) = xt_ * (R##s * invs[jj]); } while (0)
            {
                u32x4 R0u[4], R1u[4], R2u[4], R3u[4], R0n, R1n, R2n, R3n; int R0b, R1b, R2b, R3b; float R0s, R1s, R2s, R3s;
                { const int b0 = dirn ? 31 : 0;
                  PU_IDS(R0, 0, b0); PU_IDS(R1, 1, b0); PU_IDS(R2, 2, b0); PU_IDS(R3, 3, b0);
                  PU_LOAD(R0, 0, b0); PU_LOAD(R1, 1, b0); PU_LOAD(R2, 2, b0); PU_LOAD(R3, 3, b0);
                  PU_IDS(R0, 4, b0); PU_IDS(R1, 5, b0); PU_IDS(R2, 6, b0); PU_IDS(R3, 7, b0); }
#pragma unroll 1
                for (int bi = 0; bi < 32; ++bi) {
                    const int b = dirn ? 31 - bi : bi, bn = dirn ? max(b - 1, 0) : min(b + 1, 31);
                    __builtin_amdgcn_s_barrier();
                    PU_COMP(R0, 0); PU_LOAD(R0, 4, b); PU_IDS(R0, 0, bn);
                    PU_COMP(R1, 1); PU_LOAD(R1, 5, b); PU_IDS(R1, 1, bn);
                    PU_COMP(R2, 2); PU_LOAD(R2, 6, b); PU_IDS(R2, 2, bn);
                    PU_COMP(R3, 3); PU_LOAD(R3, 7, b); PU_IDS(R3, 3, bn);
                    PU_COMP(R0, 4); PU_LOAD(R0, 0, bn); PU_IDS(R0, 4, bn);
                    PU_COMP(R1, 5); PU_LOAD(R1, 1, bn); PU_IDS(R1, 5, bn);
                    PU_COMP(R2, 6); PU_LOAD(R2, 2, bn); PU_IDS(R2, 6, bn);
                    PU_COMP(R3, 7); PU_LOAD(R3, 3, bn); PU_IDS(R3, 7, bn);
                }
            }
#undef PU_IDS
#undef PU_LOAD
#undef PU_COMP
            asm volatile("s_waitcnt lgkmcnt(0)" ::: "memory");
#pragma unroll
            for (int j = 0; j < NTK; ++j) {
                unsigned* sc = (unsigned*)(wl + j * PS_TOK + 512);
                float cc_[2];
#pragma unroll
                for (int q = 0; q < 2; ++q) {
                    const float gq_ = __builtin_bit_cast(float, sc[lane + 64 * q]), dv_ = __builtin_bit_cast(float, sc[128 + lane + 64 * q]);
                    const float av_ = fabsf(dv_), tt_ = __builtin_amdgcn_rcpf(av_ * 0.2316418882f + 1.0f);
                    float qq_ = tt_ * 0.5307027145f + (-0.7265760135f); qq_ = qq_ * tt_ + 0.7107068705f; qq_ = qq_ * tt_ + (-0.142248368f); qq_ = qq_ * tt_ + 0.127414796f; qq_ = qq_ * tt_;
                    const float mm_ = dv_ * (qq_ * __builtin_amdgcn_exp2f((dv_ * dv_) * (-0.72134752044f))); cc_[q] = gq_ * (dv_ < 0.f ? mm_ : dv_ - mm_); }
                const float c0 = cc_[0], c1 = cc_[1];
                const float m = fmaxf(wave_max_u(fmaxf(fabsf(c0), fabsf(c1))), 1e-30f);
                const float S = 240.f / m; if (lane == 0) *(float*)(wl + NTK * PS_TOK + 2048 + 4 * j) = m * (1.f / 240.f);
                const float s0 = c0 * S, s1 = c1 * S;
                const int pk = __builtin_amdgcn_cvt_pk_fp8_f32(s0, s1, 0, false); const f32x2 b = __builtin_amdgcn_cvt_pk_f32_fp8(pk, false);
                const int pq = __builtin_amdgcn_cvt_pk_fp8_f32(s0 - b.x, s1 - b.y, 0, false);
                const unsigned* sl = (const unsigned*)(wl + j * PS_TOK);
                sc[lane] = sl[lane] | (((unsigned)pk & 0xffu) << 16) | (((unsigned)pq & 0xffu) << 24); sc[64 + lane] = sl[64 + lane] | (((unsigned)pk & 0xff00u) << 8) | (((unsigned)pq & 0xff00u) << 16);
            }
        }
        asm volatile("s_waitcnt lgkmcnt(0)" ::: "memory");
        {
            const int sh8 = n16 < 8 ? 16 : 24, shp = 8 * (n16 & 7);
#define PV_IDS(R, jj, qq) do { const int q_ = min((qq), 31); const int b_ = vd ? q_ : 31 - q_; R##w = *(const unsigned*)(wl + (jj) * PS_TOK + 512 + 16 * b_ + 4 * rg); } while (0)
#define PV_LOAD(R) do { R##v = *(const u32x4*)(V8 + (size_t)(R##w & 0xffffu) * D + 16 * n16 + 256 * hp); R##g = R##w; } while (0)
#define PV_COMP(R, jj) do { const i64_t a_ = (i64_t)((unsigned long long)((R##g >> sh8) & 0xffu) << shp); \
                av[jj][0] = MFMA8(a_, lo64(R##v), av[jj][0]); av[jj][1] = MFMA8(a_, hi64(R##v), av[jj][1]); } while (0)
#define PV_STEP(R, jj, qq) do { PV_COMP(R, jj); PV_LOAD(R); PV_IDS(R, jj, qq); __builtin_amdgcn_sched_barrier(0); } while (0)
#define PV_ALL(X_, qq) do { X_(A, 0, qq); X_(B, 1, qq); X_(C, 2, qq); X_(E, 3, qq); X_(F, 4, qq); X_(G, 5, qq); X_(I, 6, qq); X_(J, 7, qq); } while (0)
#define PV_IDS0(R, jj, qq) PV_IDS(R##0, jj, qq)
#define PV_IDS1(R, jj, qq) PV_IDS(R##1, jj, qq)
#define PV_LOAD0(R, jj, qq) PV_LOAD(R##0)
#define PV_LOAD1(R, jj, qq) PV_LOAD(R##1)
#define PV_STEP0(R, jj, qq) PV_STEP(R##0, jj, qq)
#define PV_STEP1(R, jj, qq) PV_STEP(R##1, jj, qq)
#pragma unroll 1
            for (int hp = 0; hp < 4; ++hp) {
                const int vd = (dirn ^ hp) & 1;
                f32x4 av[NTK][2];
#pragma unroll
                for (int j = 0; j < NTK; ++j) { av[j][0] = (f32x4){0.f, 0.f, 0.f, 0.f}; av[j][1] = (f32x4){0.f, 0.f, 0.f, 0.f}; }
                {
                    u32x4 A0v, A1v, B0v, B1v, C0v, C1v, E0v, E1v, F0v, F1v, G0v, G1v, I0v, I1v, J0v, J1v;
                    unsigned A0w, A1w, B0w, B1w, C0w, C1w, E0w, E1w, F0w, F1w, G0w, G1w, I0w, I1w, J0w, J1w, A0g, A1g, B0g, B1g, C0g, C1g, E0g, E1g, F0g, F1g, G0g, G1g, I0g, I1g, J0g, J1g;
                    PV_ALL(PV_IDS0, 0); PV_ALL(PV_IDS1, 1);
                    PV_ALL(PV_LOAD0, 0); PV_ALL(PV_LOAD1, 0);
                    PV_ALL(PV_IDS0, 2); PV_ALL(PV_IDS1, 3);
#pragma unroll 1
                    for (int q = 0; q < 32; q += 2) { __builtin_amdgcn_s_barrier(); PV_ALL(PV_STEP0, q + 4); PV_ALL(PV_STEP1, q + 5); }
                }
                const int lq = lv(lane), pe = lq >> 5, col0 = 16 * (lq & 15) + 8 * (lq >> 5) + 4 * ((lq >> 4) & 1);
#pragma unroll
                for (int j = 0; j < NTK; ++j) {
                    const int t = tb + j, grp = grp_of(t);
                    const float* gt = MOD + (size_t)(l * 3 + grp) * 6144 + 5 * D + col0 + 256 * hp; bf16* xr = X + (size_t)t * D + col0 + 256 * hp;
                    const f32x4 mine = pe ? av[j][1] : av[j][0], send = pe ? av[j][0] : av[j][1];
                    f32x4 yv;
                    const float isc = *(const float*)(wl + NTK * PS_TOK + 2048 + 4 * j);
#pragma unroll
                    for (int q = 0; q < 4; ++q) yv[q] = (mine[q] + __shfl_xor(send[q], 32)) * isc;
                    const f32x4 xv = bf4f(*(const u32x2*)xr), gv = *(const f32x4*)gt;
                    const f32x4 r = xv + gv * yv;
                    *(u32x2*)xr = (u32x2){pk2(r.x, r.y), pk2(r.z, r.w)};
                }
            }
#undef PV_IDS
#undef PV_LOAD
#undef PV_COMP
#undef PV_STEP
#undef PV_ALL
#undef PV_IDS0
#undef PV_IDS1
#undef PV_LOAD0
#undef PV_LOAD1
#undef PV_STEP0
#undef PV_STEP1
            asm volatile("s_waitcnt vmcnt(0)" ::: "memory");
            const int lq = lv(lane), col0 = 16 * (lq & 15) + 8 * (lq >> 5) + 4 * ((lq >> 4) & 1);
#pragma unroll
            for (int j = 0; j < NTK; ++j) {
                const int t = tb + j, grp = grp_of(t);
                const bf16* xr = X + (size_t)t * D + col0;
                f32x4 x2[4];
                float ssq = 0.f;
#pragma unroll
                for (int c = 0; c < 4; ++c) { x2[c] = bf4f(*(const u32x2*)(xr + 256 * c)); ssq += x2[c].x * x2[c].x + x2[c].y * x2[c].y + x2[c].z * x2[c].z + x2[c].w * x2[c].w; }
                const float ss = wave_sum(ssq);
                const float rr = 1.0f / sqrtf(ss * (1.f / D) + EPS);
                if (l < NLAYER - 1) {
                    const float* m = MOD + (size_t)((l + 1) * 3 + grp) * 6144 + col0; const float* gain = a.in[I_N1] + (l + 1) * D + col0;
#pragma unroll
                    for (int c = 0; c < 4; ++c) {
                        const f32x4 gn = *(const f32x4*)(gain + 256 * c), msc = *(const f32x4*)(m + D + 256 * c), msh = *(const f32x4*)(m + 256 * c);
                        const f32x4 o = x2[c] * rr * gn * (1.f + msc) + msh;
                        *(u32x2*)(H + (size_t)t * D + col0 + 256 * c) = (u32x2){pk2(o.x, o.y), pk2(o.z, o.w)}; }
                } else {
                    const float* gain = a.in[I_FNORM] + col0; float* op = a.out + (size_t)t * D + col0;
#pragma unroll
                    for (int c = 0; c < 4; ++c) *(f32x4*)(op + 256 * c) = x2[c] * rr * *(const f32x4*)(gain + 256 * c);
                }
            }
        }
    }
}

__global__ void __launch_bounds__(NT, 2) mega_fwd(KArgs ka) {
    extern __shared__ __attribute__((aligned(16))) unsigned char lds[];
    float* ldsf = (float*)lds;
    volatile LAS unsigned* MISC = (volatile LAS unsigned*)((LAS unsigned char*)lds + 131072 + 320);
    if (threadIdx.x < 32) MISC[threadIdx.x] = 0u;
    volatile LAS unsigned* TBL = (volatile LAS unsigned*)((LAS unsigned char*)lds + 131072 + 512);
    if (threadIdx.x == 0) {
#pragma unroll
        for (int i = 0; i < 27; ++i) { const unsigned long long p = (unsigned long long)((const unsigned char*)ka.in[i] - ka.ws); TBL[2 * i] = (unsigned)p; TBL[2 * i + 1] = (unsigned)(p >> 32); }
    }
    Args a; a.in.t = TBL; a.in.ws = ka.ws; a.out = ka.out; a.ws = ka.ws;
    __syncthreads();
    XcdBarrier bar = xcd_barrier_post((unsigned*)(a.ws + WS_CTL) + CW_BAR, MISC + 8);
#define GRID_BAR() xcd_barrier(bar)
        PG8_LAS unsigned char* glds = (PG8_LAS unsigned char*)lds;
#define FA fresh(a)
#define WSP(T, off) ((T*)(fresh(a).ws + (off)))
#define MODL (WSP(const float, WS_MOD) + (size_t)l * 3 * 6144)
    constexpr int NPH = 8, NSTEP = 2 + NLAYER * NPH;
    for (int step = 0; step < NSTEP; ++step) {
        if (step == 0) phase_prologue(fresh(a), (float*)fresh_lds(lds));
        else if (step == 1) { const int l = 0; phase_norm<false>(a.in[I_XP], a.in[I_XS], a.in[I_N1], MODL, 0, D, WSP(bf16, WS_H)); }
        else {
            const int l = (step - 2) / NPH, ph = (step - 2) % NPH;
            switch (ph) {
            case 0: { pg8::Gemm g{WSP(const bf16, WS_H), WSP(const bf16, WS_WIN_T) + (size_t)l * 2048 * D, NTOK, 2048, D}; pg8::StaticOrder S; S.init(NTOK, 2048, GDIM, BID);
                      EpiF4<FInProj> E{FInProj{WSP(bf16, WS_P), fresh(a).out, l, WSP(const float, WS_ROPE)}}; pg8::gemm_phase<EpiF4<FInProj>, pg8::StaticOrder, true, true>(glds, g, S, E); } break;
            case 1: phase_mixprep(fresh(a), l, (float*)fresh_lds(lds)); phase_gla_local(fresh(a), l, fresh_lds(lds)); break;
            case 2: phase_gla_scan(fresh(a), l); phase_attn(fresh(a), l, fresh_lds(lds)); break;
            case 3: phase_gla_out(fresh(a), l, fresh_lds(lds)); break;
            case 4: { pg8::Gemm g{WSP(const bf16, WS_MIX), WSP(const bf16, WS_WOUT_T) + (size_t)l * D * D, NTOK, D, D}; pg8::StaticOrder S; S.init(NTOK, D, GDIM, BID);
                      EpiF4<FResid> E{FResid{WSP(bf16, WS_X), a.in[I_XP], a.in[I_XS], l == 0 ? (const bf16*)nullptr : WSP(const bf16, WS_X), MODL, 2 * D}}; pg8::gemm_phase<EpiF4<FResid>, pg8::StaticOrder, false, true>(glds, g, S, E); } break;
            case 5: phase_norm<true>(WSP(const bf16, WS_X), nullptr, a.in[I_N2] + l * D, MODL, 3 * D, 4 * D, WSP(bf16, WS_H)); break;
            case 6: { pg8::Gemm g{WSP(const bf16, WS_H), WSP(const bf16, WS_WQ_T) + (size_t)l * D * D, NTOK, D, D}; pg8::StaticOrder S; S.init(NTOK, D, GDIM, BID);
                      EpiF4<FStore> E{FStore{WSP(bf16, WS_Q)}}; pg8::gemm_phase<EpiF4<FStore>, pg8::StaticOrder, false, true>(glds, g, S, E); } phase_cvt_tables(fresh(a), l); break;
            default: phase_peer(fresh(a), l, fresh_lds(lds)); break;
            }
        }
        if (step != NSTEP - 1) xcd_barrier(bar);
    }
}


extern "C" void kernel_launch(void* const* d_in, const int* in_sizes, int n_in, void* d_out, int out_size, void* d_ws, size_t ws_size, hipStream_t stream) {
    static int grid = 0;
    if (grid == 0) {
        if (n_in != 27 || ws_size < WS_END) { fprintf(stderr, "kernel_launch: unexpected n_in %d / ws %zu\n", n_in, ws_size); grid = -1; return; }
        int dev = 0, cus = 0;
        if (hipGetDevice(&dev) != hipSuccess || hipDeviceGetAttribute(&cus, hipDeviceAttributeMultiprocessorCount, dev) != hipSuccess) { grid = -1; return; }
        if (hipFuncSetAttribute((const void*)mega_fwd, hipFuncAttributeMaxDynamicSharedMemorySize, LDS_BYTES) != hipSuccess) { fprintf(stderr, "kernel_launch: hipFuncSetAttribute failed\n"); grid = -1; return; }
        int per_cu = 0;
        if (hipOccupancyMaxActiveBlocksPerMultiprocessor(&per_cu, (const void*)mega_fwd, NT, LDS_BYTES) != hipSuccess || per_cu < 1) fprintf(stderr, "kernel_launch: occupancy query says %d\n", per_cu);
        (void)hipGetLastError();
        grid = cus;
    }
    if (grid < 0) return;
    if (hipMemsetAsync((char*)d_ws + WS_CTL, 0, CTL_ZERO_BYTES, stream) != hipSuccess) return;
    KArgs a{};
    for (int i = 0; i < 27; ++i) a.in[i] = (const float*)d_in[i];
    a.out = (float*)d_out; a.ws = (unsigned char*)d_ws;
    hipLaunchKernelGGL(mega_fwd, dim3(grid), dim3(NT), LDS_BYTES, stream, a);
}
```
